# Optimizing an MI355X kernel written in HIP

```python
import math
import jax
import jax.numpy as jnp
from jax import lax
import numpy as np

D_MODEL = 1024
BATCH = 2
SEQ = 8192
DEPTH = 4

HEAD_DIM = 64
N_GROUPS = 4
GROUP_WIDTH = D_MODEL // N_GROUPS
H_FOX = GROUP_WIDTH // HEAD_DIM
H_DIFF = GROUP_WIDTH // HEAD_DIM
DIFF_QK_DIM = HEAD_DIM // 2
H_DSA = GROUP_WIDTH // HEAD_DIM
H_IDX = 4
D_IDX = 64
K_SEL_MAX = 256
CONV_CH = GROUP_WIDTH
CONV_WIDTH = 31
Q_BLOCK = 128
NUM_BUCKETS = 32
MAX_DISTANCE = 128
N_BIAS_HEADS = H_DIFF + H_DSA
N_EXPERTS = 32
TOP_K = 4
D_FF = D_MODEL
SWIGLU_LIMIT = 7.0
SWIGLU_ALPHA = 1.702
FORGET_BIAS_INIT = 4.0
DEEPNORM_ALPHA = (2 * DEPTH) ** 0.25
DEEPNORM_BETA = (8 * DEPTH) ** -0.25
LN_EPS = 1e-5

IN_WIDTHS = (GROUP_WIDTH, GROUP_WIDTH, GROUP_WIDTH, H_FOX,
             GROUP_WIDTH, GROUP_WIDTH, GROUP_WIDTH,
             GROUP_WIDTH, GROUP_WIDTH, GROUP_WIDTH, H_IDX * D_IDX, D_IDX, H_IDX,
             2 * CONV_CH)
N_IN = sum(IN_WIDTHS)
SPLIT_POINTS = tuple(sum(IN_WIDTHS[:i + 1]) for i in range(len(IN_WIDTHS) - 1))
V_SLOTS = (2, 6, 9)
F_SLOT = 3

kernel_name = "hybrid_fox_diff_dsa_conformer_moe_deepnorm"


def _to_blocks(a):
    b, l = a.shape[0], a.shape[1]
    a = a.reshape((b, l // Q_BLOCK, Q_BLOCK) + a.shape[2:])
    return jnp.swapaxes(a, 0, 1)


def _from_blocks(a):
    a = jnp.swapaxes(a, 0, 1)
    return a.reshape((a.shape[0], a.shape[1] * a.shape[2]) + a.shape[3:])


def _layernorm(x, g, b):
    xf = x.astype(jnp.float32)
    mu = jnp.mean(xf, axis=-1, keepdims=True)
    var = jnp.mean(jnp.square(xf - mu), axis=-1, keepdims=True)
    y = (xf - mu) * lax.rsqrt(var + LN_EPS)
    return (y * g.astype(jnp.float32) + b.astype(jnp.float32)).astype(x.dtype)


def _rel_bucket(dist):
    n = jnp.maximum(dist, 0)
    max_exact = NUM_BUCKETS // 2
    nf = jnp.maximum(n, 1).astype(jnp.float32)
    large = max_exact + (jnp.log(nf / max_exact) / math.log(MAX_DISTANCE / max_exact)
                         * (NUM_BUCKETS - max_exact)).astype(jnp.int32)
    large = jnp.minimum(large, NUM_BUCKETS - 1)
    return jnp.where(n < max_exact, n, large)


def forgetting_attention(q, k, v, log_f):
    L = q.shape[1]
    c = jnp.cumsum(log_f.astype(jnp.float32), axis=1)
    c_k = jnp.swapaxes(c, 1, 2)[:, :, None, :]
    k_pos = jnp.arange(L, dtype=jnp.int32)
    scale = HEAD_DIM ** -0.5

    def block(args):
        qb, cb, i = args
        q_pos = i * Q_BLOCK + jnp.arange(Q_BLOCK, dtype=jnp.int32)
        s = jnp.einsum("bqhd,bkhd->bhqk", qb, k).astype(jnp.float32) * scale
        s = s + jnp.swapaxes(cb, 1, 2)[..., None] - c_k
        s = jnp.where(k_pos[None, :] <= q_pos[:, None], s, -jnp.inf)
        p = jax.nn.softmax(s, axis=-1).astype(v.dtype)
        return jnp.einsum("bhqk,bkhd->bqhd", p, v)

    nb = L // Q_BLOCK
    out = lax.map(block, (_to_blocks(q), _to_blocks(c), jnp.arange(nb, dtype=jnp.int32)))
    return _from_blocks(out)


def differential_attention(q, k, v, lam, bias_table):
    L = q.shape[1]
    k_pos = jnp.arange(L, dtype=jnp.int32)
    scale = DIFF_QK_DIM ** -0.5

    def block(args):
        qb, i = args
        q_pos = i * Q_BLOCK + jnp.arange(Q_BLOCK, dtype=jnp.int32)
        s = jnp.einsum("bqhmd,bkhmd->bhmqk", qb, k).astype(jnp.float32) * scale
        bias = bias_table[_rel_bucket(q_pos[:, None] - k_pos[None, :])]
        s = s + jnp.transpose(bias, (2, 0, 1))[None, :, None].astype(jnp.float32)
        s = jnp.where(k_pos[None, :] <= q_pos[:, None], s, -jnp.inf)
        p = jax.nn.softmax(s, axis=-1)
        p = p[:, :, 0] - lam * p[:, :, 1]
        return jnp.einsum("bhqk,bkhd->bqhd", p.astype(v.dtype), v)

    nb = L // Q_BLOCK
    out = lax.map(block, (_to_blocks(q), jnp.arange(nb, dtype=jnp.int32)))
    return _from_blocks(out)


def indexed_sparse_attention(q, k, v, q_idx, k_idx, w_idx, bias_table, top_k):
    L = q.shape[1]
    k_pos = jnp.arange(L, dtype=jnp.int32)
    scale = HEAD_DIM ** -0.5

    def block(args):
        qb, qib, wb, i = args
        q_pos = i * Q_BLOCK + jnp.arange(Q_BLOCK, dtype=jnp.int32)
        sc = jnp.einsum("bqhd,bkd->bqhk", qib, k_idx).astype(jnp.float32) * (D_IDX ** -0.5)
        score = jnp.einsum("bqh,bqhk->bqk", wb.astype(jnp.float32), jax.nn.relu(sc)) * (H_IDX ** -0.5)
        score = jnp.where(k_pos[None, None, :] <= q_pos[None, :, None], score, -jnp.inf)
        _, idx = lax.top_k(score, top_k)
        valid = idx <= q_pos[None, :, None]
        kg = jax.vmap(lambda a, j: a[j])(k, idx)
        vg = jax.vmap(lambda a, j: a[j])(v, idx)
        s = jnp.einsum("bqhd,bqkhd->bhqk", qb, kg).astype(jnp.float32) * scale
        bias = bias_table[_rel_bucket(q_pos[None, :, None] - idx)]
        s = s + jnp.transpose(bias, (0, 3, 1, 2)).astype(jnp.float32)
        s = jnp.where(valid[:, None], s, -jnp.inf)
        p = jax.nn.softmax(s, axis=-1).astype(v.dtype)
        return jnp.einsum("bhqk,bqkhd->bqhd", p, vg)

    nb = L // Q_BLOCK
    out = lax.map(block, (_to_blocks(q), _to_blocks(q_idx), _to_blocks(w_idx),
                          jnp.arange(nb, dtype=jnp.int32)))
    return _from_blocks(out)


def conformer_conv(u, conv_w, conv_b, ln_g, ln_b):
    a, g = jnp.split(u, 2, axis=-1)
    h = a * jax.nn.sigmoid(g)
    h = lax.conv_general_dilated(h, conv_w[:, None, :], window_strides=(1,),
                                 padding=((CONV_WIDTH - 1, 0),),
                                 dimension_numbers=("NWC", "WIO", "NWC"),
                                 feature_group_count=CONV_CH) + conv_b
    h = _layernorm(h, ln_g, ln_b)
    return h * jax.nn.sigmoid(h)


def token_mixers(x, rel_bias, w_in, forget_b, diff_lambda, diff_norm_g, conv_w, conv_b,
                 conv_ln_g, conv_ln_b, w_out, lambda_init):
    B, L, _ = x.shape
    proj = x @ w_in
    (fq, fk, fv, ff, dq, dk, dv, sq, sk, sv, iq, ik, iw, cu) = jnp.split(proj, SPLIT_POINTS, axis=-1)

    log_f = jax.nn.log_sigmoid((ff + forget_b).astype(jnp.float32))
    y_fox = forgetting_attention(fq.reshape(B, L, H_FOX, HEAD_DIM), fk.reshape(B, L, H_FOX, HEAD_DIM),
                                 fv.reshape(B, L, H_FOX, HEAD_DIM), log_f)

    lp = diff_lambda.astype(jnp.float32)
    lam = jnp.exp(jnp.sum(lp[0] * lp[1])) - jnp.exp(jnp.sum(lp[2] * lp[3])) + lambda_init
    y_diff = differential_attention(dq.reshape(B, L, H_DIFF, 2, DIFF_QK_DIM),
                                    dk.reshape(B, L, H_DIFF, 2, DIFF_QK_DIM),
                                    dv.reshape(B, L, H_DIFF, HEAD_DIM), lam, rel_bias[:, :H_DIFF])
    yf = y_diff.astype(jnp.float32)
    yf = yf * lax.rsqrt(jnp.mean(jnp.square(yf), axis=-1, keepdims=True) + LN_EPS)
    y_diff = (yf * diff_norm_g.astype(jnp.float32) * (1.0 - lambda_init)).astype(x.dtype)

    top_k = min(K_SEL_MAX, L // 4)
    y_dsa = indexed_sparse_attention(sq.reshape(B, L, H_DSA, HEAD_DIM), sk.reshape(B, L, H_DSA, HEAD_DIM),
                                     sv.reshape(B, L, H_DSA, HEAD_DIM), iq.reshape(B, L, H_IDX, D_IDX),
                                     ik, iw, rel_bias[:, H_DIFF:], top_k)

    y_conv = conformer_conv(cu, conv_w, conv_b, conv_ln_g, conv_ln_b)

    y = jnp.concatenate([y_fox.reshape(B, L, GROUP_WIDTH), y_diff.reshape(B, L, GROUP_WIDTH),
                         y_dsa.reshape(B, L, GROUP_WIDTH), y_conv], axis=-1)
    return y @ w_out


def moe_ffn(x, router_w, router_b, w_gu, b_gu, w_down, b_down):
    B, L, D = x.shape
    t = x.reshape(B * L, D)
    logits = (t @ router_w + router_b).astype(jnp.float32)
    top_val, top_idx = lax.top_k(logits, TOP_K)
    wts = jax.nn.softmax(top_val, axis=-1)
    gates = jnp.sum(jax.nn.one_hot(top_idx, N_EXPERTS, dtype=jnp.float32) * wts[..., None], axis=1)
    out = jnp.zeros((B * L, D), jnp.float32)
    for e in range(N_EXPERTS):
        gu = t @ w_gu[e] + b_gu[e]
        gate = jnp.minimum(gu[:, ::2], SWIGLU_LIMIT)
        up = jnp.clip(gu[:, 1::2], -SWIGLU_LIMIT, SWIGLU_LIMIT)
        h = (up + 1.0) * gate * jax.nn.sigmoid(gate * SWIGLU_ALPHA)
        out = out + gates[:, e:e + 1] * (h @ w_down[e] + b_down[e])
    return out.astype(x.dtype).reshape(B, L, D)


def setup_inputs(seed: int = 0) -> dict:
    key = jax.random.key(seed)
    ks = jax.random.split(key, 22)

    def nrm(k, shape, scale):
        return jax.random.normal(k, shape, jnp.float32) * scale

    slot_scale = [1.0] * len(IN_WIDTHS)
    for s in V_SLOTS:
        slot_scale[s] = DEEPNORM_BETA
    slot_scale[F_SLOT] = 0.1
    col_scale = jnp.asarray(np.concatenate(
        [np.full((w,), sc, np.float32) for w, sc in zip(IN_WIDTHS, slot_scale)]))

    return {
        "x": nrm(ks[0], (BATCH, SEQ, D_MODEL), 1.0),
        "rel_bias": nrm(ks[1], (NUM_BUCKETS, N_BIAS_HEADS), 0.2),
        "w_in": nrm(ks[2], (DEPTH, D_MODEL, N_IN), D_MODEL ** -0.5) * col_scale,
        "forget_b": FORGET_BIAS_INIT + nrm(ks[3], (DEPTH, H_FOX), 0.1),
        "diff_lambda": nrm(ks[4], (DEPTH, 4, DIFF_QK_DIM), 0.1),
        "diff_norm_g": 1.0 + nrm(ks[5], (DEPTH, HEAD_DIM), 0.01),
        "conv_w": nrm(ks[6], (DEPTH, CONV_WIDTH, CONV_CH), CONV_WIDTH ** -0.5),
        "conv_b": nrm(ks[7], (DEPTH, CONV_CH), 0.01),
        "conv_ln_g": 1.0 + nrm(ks[8], (DEPTH, CONV_CH), 0.01),
        "conv_ln_b": nrm(ks[9], (DEPTH, CONV_CH), 0.01),
        "w_out": nrm(ks[10], (DEPTH, D_MODEL, D_MODEL), D_MODEL ** -0.5 * DEEPNORM_BETA),
        "ln1_g": 1.0 + nrm(ks[11], (DEPTH, D_MODEL), 0.01),
        "ln1_b": nrm(ks[12], (DEPTH, D_MODEL), 0.01),
        "router_w": nrm(ks[13], (DEPTH, D_MODEL, N_EXPERTS), D_MODEL ** -0.5),
        "router_b": nrm(ks[14], (DEPTH, N_EXPERTS), 0.01),
        "w_gu": nrm(ks[15], (DEPTH, N_EXPERTS, D_MODEL, 2 * D_FF), D_MODEL ** -0.5 * DEEPNORM_BETA),
        "b_gu": nrm(ks[16], (DEPTH, N_EXPERTS, 2 * D_FF), 0.01),
        "w_down": nrm(ks[17], (DEPTH, N_EXPERTS, D_FF, D_MODEL), D_FF ** -0.5 * DEEPNORM_BETA),
        "b_down": nrm(ks[18], (DEPTH, N_EXPERTS, D_MODEL), 0.01),
        "ln2_g": 1.0 + nrm(ks[19], (DEPTH, D_MODEL), 0.01),
        "ln2_b": nrm(ks[20], (DEPTH, D_MODEL), 0.01),
    }


def reference(x, rel_bias, w_in, forget_b, diff_lambda, diff_norm_g, conv_w, conv_b, conv_ln_g,
              conv_ln_b, w_out, ln1_g, ln1_b, router_w, router_b, w_gu, b_gu, w_down, b_down,
              ln2_g, ln2_b):
    for l in range(DEPTH):
        lambda_init = 0.8 - 0.6 * math.exp(-0.3 * l)
        mix = token_mixers(x, rel_bias, w_in[l], forget_b[l], diff_lambda[l], diff_norm_g[l],
                           conv_w[l], conv_b[l], conv_ln_g[l], conv_ln_b[l], w_out[l], lambda_init)
        x = _layernorm(DEEPNORM_ALPHA * x + mix, ln1_g[l], ln1_b[l])
        ffn = moe_ffn(x, router_w[l], router_b[l], w_gu[l], b_gu[l], w_down[l], b_down[l])
        x = _layernorm(DEEPNORM_ALPHA * x + ffn, ln2_g[l], ln2_b[l])
    return x
```

```cpp
#include <hip/hip_runtime.h>
#include <hip/hip_bf16.h>
#include <cstdio>
#include <cstdint>
#include <cmath>

#define LAS __attribute__((address_space(3)))
typedef unsigned short bf16_t;
typedef short bf16x8 __attribute__((ext_vector_type(8)));
typedef short s16x4 __attribute__((ext_vector_type(4)));
typedef float f32x4 __attribute__((ext_vector_type(4)));
typedef float f32x2 __attribute__((ext_vector_type(2)));
typedef float f32x16 __attribute__((ext_vector_type(16)));
typedef unsigned u32x4 __attribute__((ext_vector_type(4)));
typedef unsigned u32x2 __attribute__((ext_vector_type(2)));
typedef __bf16 bf16x2_t __attribute__((ext_vector_type(2)));

constexpr int NB = 2, SEQ = 8192, T = NB * SEQ, D = 1024, DEPTH = 4;
constexpr int NIN = 3144, PW = 3328;
constexpr int C_FQ = 0, C_FK = 256, C_FV = 512, C_DQ = 768, C_DK = 1024, C_DV = 1280, C_SQ = 1536, C_SK = 1792, C_SV = 2048, C_IQ = 2304, C_IK = 2560, C_CU = 2624, C_FF = 3136, C_IW = 3140;
constexpr int NE = 32, TOPK = 4, ECAP = T;
constexpr int MAXTILES = 288;
constexpr float LN_EPS = 1e-5f;
constexpr float DN_ALPHA = 1.681792830507429f;
constexpr float LOG2E = 1.4426950408889634f;
constexpr int NWAVES = 8, NTHR = 512;

constexpr size_t MiB = 1u << 20;
constexpr size_t WS_CTL = 0, CTL_ZERO_BYTES = 1 * MiB;
constexpr size_t WS_WIN = 1 * MiB;
constexpr size_t WS_WOUT = 27 * MiB;
constexpr size_t WS_RWT = 35 * MiB;
constexpr size_t WS_WGU = 36 * MiB;
constexpr size_t WS_WDN = 548 * MiB;
constexpr size_t WS_XF = 804 * MiB;
constexpr size_t WS_XB = 868 * MiB;
constexpr size_t WS_PROJ = 900 * MiB;
constexpr size_t WS_Y = 1004 * MiB;
constexpr size_t WS_PRE = 1036 * MiB;
constexpr size_t WS_X1F = 1100 * MiB;
constexpr size_t WS_X1B = 1164 * MiB;
constexpr size_t WS_SEL = 1196 * MiB;
constexpr size_t WS_SCR = 1212 * MiB;
constexpr size_t WS_TOK = 1468 * MiB;
constexpr size_t WS_PE = 1470 * MiB;
constexpr size_t WS_H = 1472 * MiB;
constexpr size_t WS_Y2 = 1616 * MiB;
constexpr size_t WS_END = 1760 * MiB;
constexpr int CW_BAR = 0;
constexpr int CW_Q = 4096;
constexpr int CW_ECNT = 8192;

constexpr int RING_BYTES = 131072;
constexpr int LDS_TAB = RING_BYTES;
constexpr int LDS_MISC = RING_BYTES + 2048;
constexpr int LDS_BYTES = 147456;

__device__ __forceinline__ float bf2f(bf16_t v) { return __uint_as_float((unsigned)v << 16); }
__device__ __forceinline__ unsigned cvtpk(float lo, float hi) { f32x2 v = {lo, hi}; bf16x2_t b = __builtin_convertvector(v, bf16x2_t); return __builtin_bit_cast(unsigned, b); }
__device__ __forceinline__ bf16_t f2bf(float f) { return (bf16_t)(cvtpk(f, 0.f) & 0xffffu); }
__device__ __forceinline__ float wave_sum(float v) {
#pragma unroll
    for (int o = 1; o < 64; o <<= 1) v += __shfl_xor(v, o);
    return v;
}
__device__ __forceinline__ float sigmoidf_(float x) { return 1.0f / (1.0f + __expf(-x)); }
__device__ __forceinline__ int lane_id_() { return (int)__builtin_amdgcn_mbcnt_hi(~0u, __builtin_amdgcn_mbcnt_lo(~0u, 0u)); }
#define LDS_WAIT() asm volatile("s_waitcnt lgkmcnt(0)" ::: "memory")
#define VM_WAIT() asm volatile("s_waitcnt vmcnt(0)" ::: "memory")

#define XB_TMO      128
#define XB_XCNT(j)  (256  + 64 * (j))
#define XB_XSUB(j)  (1280 + 64 * (j))
#define XB_XGEN(j)  (2304 + 64 * (j))
#define XB_TOP      3328
#define XB_TOPGEN   3392
#define XCD_BAR_WORDS 3456
#define XB_SPIN_CAP (1u << 20)

__device__ __forceinline__ unsigned xb_ld(unsigned* p)              { return __hip_atomic_load(p, __ATOMIC_RELAXED, __HIP_MEMORY_SCOPE_AGENT); }
__device__ __forceinline__ unsigned xb_add(unsigned* p, unsigned v) { return __hip_atomic_fetch_add(p, v, __ATOMIC_RELAXED, __HIP_MEMORY_SCOPE_AGENT); }
__device__ __forceinline__ unsigned xb_xcc_id() { return (unsigned)__builtin_amdgcn_s_getreg((3 << 11) | 20) & 0xFu; }
#define XB_SPIN(cond, bar) do { unsigned _sp = 0; while (cond) { __builtin_amdgcn_s_sleep(1); \
    if ((++_sp & 255u) == 0u) { if (xb_ld(&(bar)[XB_TMO])) break; if (_sp > XB_SPIN_CAP) { atomicAdd(&(bar)[XB_TMO], 1u); break; } } } } while (0)

struct XcdBarrier { unsigned* bar; unsigned x; volatile LAS unsigned* st; };

__device__ __forceinline__ XcdBarrier xcd_barrier_post(unsigned* bar, volatile LAS unsigned* st, int tid) {
    XcdBarrier b; b.bar = bar; b.x = xb_xcc_id(); b.st = st;
    if (tid == 0) (void)xb_add(&bar[XB_XCNT(b.x)], 1u);
    return b;
}
__device__ __forceinline__ void xcd_barrier_complete(unsigned* bar, unsigned x, unsigned& nloc, unsigned& nx) {
    const unsigned G = gridDim.x * gridDim.y * gridDim.z;
    unsigned sum, cnt, mine, sp = 0u;
    for (;;) {
        sum = 0u; cnt = 0u; mine = 0u;
#pragma unroll
        for (unsigned j = 0; j < 16; ++j) { const unsigned c = xb_ld(&bar[XB_XCNT(j)]); sum += c; cnt += (c > 0u) ? 1u : 0u; mine = (j == x) ? c : mine; }
        if (sum == G) break;
        __builtin_amdgcn_s_sleep(1);
        if ((++sp & 255u) == 0u) { if (xb_ld(&bar[XB_TMO])) break; if (sp > XB_SPIN_CAP) { atomicAdd(&bar[XB_TMO], 1u); break; } }
    }
    nloc = mine > 0u ? mine : 1u; nx = cnt > 0u ? cnt : 1u;
}
__device__ __forceinline__ void xcd_barrier(const XcdBarrier& b, int wid0) {
    asm volatile("s_waitcnt vmcnt(0)" ::: "memory");
    __syncthreads();
    if (wid0 == 0 && lane_id_() == 0) {
        unsigned* bar = b.bar;
        __builtin_amdgcn_s_waitcnt(0);
        unsigned nloc = b.st[0], nx = b.st[1];
        if (nloc == 0u) { xcd_barrier_complete(bar, b.x, nloc, nx); b.st[0] = nloc; b.st[1] = nx; }
        const unsigned old = xb_add(&bar[XB_XSUB(b.x)], 1u);
        const unsigned gen = old / nloc;
        if (old + 1u == (gen + 1u) * nloc) {
            __builtin_amdgcn_fence(__ATOMIC_RELEASE, "agent");
            asm volatile("s_waitcnt vmcnt(0)" ::: "memory");
            const unsigned og = xb_add(&bar[XB_TOP], 1u);
            const unsigned tg = og / nx;
            if (og + 1u == (tg + 1u) * nx) xb_add(&bar[XB_TOPGEN], 1u);
            else XB_SPIN(xb_ld(&bar[XB_TOPGEN]) == tg, bar);
            __builtin_amdgcn_fence(__ATOMIC_ACQUIRE, "agent");
            xb_add(&bar[XB_XGEN(b.x)], 1u);
            asm volatile("s_waitcnt vmcnt(0)" ::: "memory");
        } else {
            XB_SPIN(xb_ld(&bar[XB_XGEN(b.x)]) == gen, bar);
            __builtin_amdgcn_fence(__ATOMIC_ACQUIRE, "agent");
            asm volatile("s_waitcnt vmcnt(0)" ::: "memory");
        }
    }
    __syncthreads();
}

namespace pg8 {
constexpr int BM = 256, BK = 64, HALF = 128, HTB = HALF * BK * 2, STAGE_BYTES = 8 * HTB, KD = 1024, VOFF_LDS = STAGE_BYTES + 4096;
__host__ __device__ __forceinline__ int lds_byte(int r, int c) { const int st = (r >> 4) * 2 + (c >> 5), rr = r & 15, cc = c & 31, ob = rr * 64 + cc * 2; return st * 1024 + (ob ^ (((ob >> 9) & 1) << 5)); }
__host__ __device__ __forceinline__ void stage_rc(int b, int& R, int& C) { const int st = b / 1024, sb = b % 1024, swz = sb ^ (((sb >> 9) & 1) << 5); R = (st >> 1) * 16 + swz / 64; C = (st & 1) * 32 + (swz % 64) / 2; }
__host__ __device__ __forceinline__ int perm32(int rho) { const int n = rho >> 4, i = rho & 15; return 8 * (i >> 2) + 4 * n + (i & 3); }

struct Unit { int pm, pn, e; };

template <class Epi, class Sched, bool ALIGN_EPI>
__device__ __forceinline__ void gemm_phase(LAS unsigned char* lds, const Sched& S, const Epi& E, const int tid) {
    const int wid = __builtin_amdgcn_readfirstlane(tid >> 6), lane = tid & 63, wr = wid >> 2, wc = wid & 3, fr = lane & 15, fq = lane >> 4;
    constexpr int K = KD, nt = K / BK;
    int Rr[2], Cc[2]; unsigned voffB[2];
#pragma unroll
    for (int i = 0; i < 2; ++i) { int R, C; stage_rc(tid * 16 + i * 8192, R, C); const int Rb = Epi::PERM ? ((R & ~31) + perm32(R & 31)) : R; Rr[i] = R; Cc[i] = C; voffB[i] = (unsigned)(Rb * K + C) * 2u; }
    constexpr size_t kstep = (size_t)(BK * 2);
    constexpr size_t hstep = (size_t)HALF * K * 2;
    const unsigned ldsw = (unsigned)wid * 1024u;
    const int aoff = lds_byte(wr * 64 + fr, fq * 8), boff = lds_byte(wc * 32 + fr, fq * 8);
#define PG8_SA(b, h) (((b) * 2 + (h)) * HTB)
#define PG8_SB(b, h) ((4 + (b) * 2 + (h)) * HTB)
#define PG8_STAGE(bufoff, gbase, voff) do { _Pragma("unroll") for (int _i = 0; _i < 2; ++_i) \
        __builtin_amdgcn_global_load_lds((const unsigned*)((const char*)(gbase) + (voff)[_i]), (LAS unsigned*)(lds + (bufoff) + ldsw + _i * 8192), 16, 0, 0); } while (0)
#define PG8_LDA(dst, b, h) do { _Pragma("unroll") for (int m = 0; m < 4; ++m) _Pragma("unroll") for (int k = 0; k < 2; ++k) dst[m][k] = *(const LAS bf16x8*)(lds + PG8_SA(b, h) + aoff + m * 2048 + k * 1024); } while (0)
#define PG8_LDB(dst, b, h) do { _Pragma("unroll") for (int n = 0; n < 2; ++n) _Pragma("unroll") for (int k = 0; k < 2; ++k) dst[n][k] = *(const LAS bf16x8*)(lds + PG8_SB(b, h) + boff + n * 2048 + k * 1024); } while (0)
#define PG8_MMA(ai, bj, At, Bt) do { __builtin_amdgcn_s_setprio(1); _Pragma("unroll") for (int m = 0; m < 4; ++m) _Pragma("unroll") for (int n = 0; n < 2; ++n) _Pragma("unroll") for (int k = 0; k < 2; ++k) \
        acc[ai][bj][m][n] = __builtin_amdgcn_mfma_f32_16x16x32_bf16(Bt[n][k], At[m][k], acc[ai][bj][m][n], 0, 0, 0); __builtin_amdgcn_s_setprio(0); } while (0)
#define PG8_WAIT_V(n) asm volatile("s_waitcnt vmcnt(" #n ")" ::: "memory")
#define PG8_WAIT_L(n) asm volatile("s_waitcnt lgkmcnt(" #n ")" ::: "memory")
#define PG8_BAR __builtin_amdgcn_s_barrier()
#define PG8_SCHED __builtin_amdgcn_sched_barrier(0)
    Unit cur, nxt; int ui = 0;
    if (!S.next(0, cur)) return;
    f32x4 acc[2][2][4][2];
#pragma unroll
    for (int a = 0; a < 2; ++a)
#pragma unroll
        for (int b = 0; b < 2; ++b)
#pragma unroll
            for (int m = 0; m < 4; ++m)
#pragma unroll
                for (int n = 0; n < 2; ++n) acc[a][b][m][n] = (f32x4){0.f, 0.f, 0.f, 0.f};
    bf16x8 At[4][2], B0[2][2], B1[2][2];
    constexpr bool GA = Sched::GATHER;
    unsigned vAc[2][2], vAn[2][2];
    if constexpr (GA) S.a_voff(cur, tid, vAc);
    else {
#pragma unroll
        for (int i = 0; i < 2; ++i) { vAc[0][i] = (unsigned)(Rr[i] * K + Cc[i]) * 2u; vAc[1][i] = vAc[0][i]; vAn[0][i] = vAc[0][i]; vAn[1][i] = vAc[0][i]; }
    }
    constexpr size_t ah = GA ? (size_t)0 : hstep;
    const char* cA = S.a_base(cur); const char* cB = S.b_base(cur);
    PG8_STAGE(PG8_SB(0, 0), cB, voffB); PG8_STAGE(PG8_SB(0, 1), cB + hstep, voffB); PG8_STAGE(PG8_SA(0, 0), cA, vAc[0]); PG8_STAGE(PG8_SA(0, 1), cA + ah, vAc[1]);
    if (wr == 1) PG8_BAR;
    PG8_WAIT_V(2); PG8_BAR;
    PG8_STAGE(PG8_SB(1, 0), cB + kstep, voffB); PG8_STAGE(PG8_SA(1, 0), cA + kstep, vAc[0]); PG8_STAGE(PG8_SB(1, 1), cB + hstep + kstep, voffB);
    PG8_WAIT_V(6); PG8_BAR;
    for (;;) {
        const bool has_next = S.next(ui + 1, nxt);
        const char* nA = has_next ? S.a_base(nxt) : cA; const char* nB = has_next ? S.b_base(nxt) : cB;
        if constexpr (GA) {
            if (has_next) S.a_voff(nxt, tid, vAn);
            else { vAn[0][0] = vAc[0][0]; vAn[0][1] = vAc[0][1]; vAn[1][0] = vAc[1][0]; vAn[1][1] = vAc[1][1]; }
            *(LAS u32x4*)(lds + VOFF_LDS + tid * 16) = (u32x4){vAn[0][0], vAn[0][1], vAn[1][0], vAn[1][1]};
        }
        for (int t = 0; t < nt; t += 2) {
            const bool last = (t == nt - 2);
            const char* a1 = cA + (size_t)(t + 1) * kstep;
            const char* a2 = last ? nA : cA + (size_t)(t + 2) * kstep; const char* b2 = last ? nB : cB + (size_t)(t + 2) * kstep;
            const char* a3 = a2 + kstep; const char* b3 = b2 + kstep;
            PG8_LDB(B0, 0, 0); PG8_LDB(B1, 0, 1); PG8_SCHED; PG8_LDA(At, 0, 0); PG8_STAGE(PG8_SA(1, 1), a1 + ah, vAc[1]);
            if constexpr (GA) { if (last) { const u32x4 nv = *(const LAS u32x4*)(lds + VOFF_LDS + tid * 16); vAc[0][0] = nv[0]; vAc[0][1] = nv[1]; vAc[1][0] = nv[2]; vAc[1][1] = nv[3]; } }
            PG8_WAIT_V(8); PG8_WAIT_L(0); PG8_BAR; PG8_MMA(0, 0, At, B0); PG8_MMA(0, 1, At, B1); PG8_BAR; PG8_SCHED;
            PG8_LDA(At, 0, 1); PG8_STAGE(PG8_SB(0, 0), b2, voffB); PG8_STAGE(PG8_SB(0, 1), b2 + hstep, voffB); PG8_STAGE(PG8_SA(0, 0), a2, vAc[0]);
            PG8_WAIT_V(8); PG8_WAIT_L(0); PG8_BAR; PG8_MMA(1, 0, At, B0); PG8_MMA(1, 1, At, B1); PG8_BAR; PG8_SCHED;
            PG8_LDB(B0, 1, 0); PG8_LDB(B1, 1, 1); PG8_SCHED; PG8_LDA(At, 1, 0); PG8_STAGE(PG8_SA(0, 1), a2 + ah, vAc[1]);
            PG8_WAIT_V(8); PG8_WAIT_L(0); PG8_BAR; PG8_MMA(0, 0, At, B0); PG8_MMA(0, 1, At, B1); PG8_BAR; PG8_SCHED;
            PG8_LDA(At, 1, 1); PG8_STAGE(PG8_SB(1, 0), b3, voffB); PG8_STAGE(PG8_SB(1, 1), b3 + hstep, voffB); PG8_STAGE(PG8_SA(1, 0), a3, vAc[0]);
            PG8_WAIT_V(8); PG8_WAIT_L(0); PG8_BAR; PG8_MMA(1, 0, At, B0); PG8_MMA(1, 1, At, B1); PG8_BAR; PG8_SCHED;
        }
        if constexpr (ALIGN_EPI) { if (wr == 0) PG8_BAR; }
        { int te = tid; asm volatile("" : "+v"(te)); const int lw = __builtin_amdgcn_readfirstlane(te >> 6); E(acc, cur, lw >> 2, lw & 3, te & 15, (te & 63) >> 4); }
        if (!has_next) break;
#pragma unroll
        for (int a = 0; a < 2; ++a)
#pragma unroll
            for (int b = 0; b < 2; ++b)
#pragma unroll
                for (int m = 0; m < 4; ++m)
#pragma unroll
                    for (int n = 0; n < 2; ++n) acc[a][b][m][n] = (f32x4){0.f, 0.f, 0.f, 0.f};
        cur = nxt; cA = nA; cB = nB; ++ui;
        if constexpr (ALIGN_EPI) { if (wr == 1) PG8_BAR; }
    }
    PG8_WAIT_V(0);
    if constexpr (!ALIGN_EPI) { if (wr == 0) PG8_BAR; }
    PG8_BAR;
#undef PG8_SA
#undef PG8_SB
#undef PG8_STAGE
#undef PG8_LDA
#undef PG8_LDB
#undef PG8_MMA
#undef PG8_WAIT_V
#undef PG8_WAIT_L
#undef PG8_BAR
#undef PG8_SCHED
}

struct DenseSched {
    const bf16_t* A; const bf16_t* Bt; int nM, nN, nwg, G, c;
    __device__ __forceinline__ void init(const bf16_t* A_, const bf16_t* Bt_, int M, int N, int G_, int c_) { A = A_; Bt = Bt_; nM = M / BM; nN = N / BM; nwg = nM * nN; G = G_; c = c_; }
    __device__ __forceinline__ bool next(int i, Unit& u) const {
        const long L = (long)i * G + c; if (L >= nwg) return false;
        int wgid = (int)L; { const int q = nwg / 8, r = nwg % 8, xcd = wgid % 8, off = wgid / 8; wgid = (xcd < r ? xcd * (q + 1) : r * (q + 1) + (xcd - r) * q) + off; }
        const int nig = 8 * nN, gid = wgid / nig, fm = gid * 8, gsz = (nM - fm) < 8 ? (nM - fm) : 8;
        u.pm = fm + ((wgid % nig) % gsz); u.pn = (wgid % nig) / gsz; u.e = 0; return true;
    }
    static constexpr bool GATHER = false;
    __device__ __forceinline__ const char* a_base(const Unit& u) const { return (const char*)A + (size_t)u.pm * BM * KD * 2; }
    __device__ __forceinline__ const char* b_base(const Unit& u) const { return (const char*)Bt + (size_t)u.pn * BM * KD * 2; }
};
struct MoeTabs { const LAS int* texp; const LAS int* tstart; const LAS int* cnt; int ntiles; };
template <bool GATHER_, int NT_N>
struct MoeSched {
    const bf16_t* A; const bf16_t* Bt; const int* tok; MoeTabs tb; int G, c;
    __device__ __forceinline__ bool next(int i, Unit& u) const {
        const long L = (long)i * G + c; if (L >= (long)tb.ntiles * NT_N) return false;
        u.pm = (int)(L / NT_N); u.pn = (int)(L % NT_N); u.e = __builtin_amdgcn_readfirstlane(tb.texp[u.pm]); return true;
    }
    static constexpr bool GATHER = GATHER_;
    __device__ __forceinline__ const char* a_base(const Unit& u) const { return GATHER_ ? (const char*)A : (const char*)A + (size_t)u.pm * BM * KD * 2; }
    __device__ __forceinline__ const char* b_base(const Unit& u) const { return (const char*)Bt + ((size_t)u.e * NT_N + u.pn) * BM * KD * 2; }
    __device__ __forceinline__ void a_voff(const Unit& u, int tid, unsigned (&v)[2][2]) const {
        const int s0 = (u.pm - __builtin_amdgcn_readfirstlane(tb.tstart[u.e])) * BM, n = __builtin_amdgcn_readfirstlane(tb.cnt[u.e]);
#pragma unroll
        for (int i = 0; i < 2; ++i) { int R, C; stage_rc(tid * 16 + i * 8192, R, C);
#pragma unroll
            for (int h = 0; h < 2; ++h) { const int s = s0 + h * HALF + R; const int tk = (s < n) ? tok[(size_t)u.e * ECAP + s] : 0; v[h][i] = (unsigned)(tk * KD + C) * 2u; } }
    }
};

struct EpiProj {
    static constexpr bool PERM = true;
    bf16_t* O;
    __device__ __forceinline__ void operator()(const f32x4 (&acc)[2][2][4][2], const Unit& u, int wr, int wc, int fr, int fq) const {
        const int row0 = u.pm * BM + wr * 64 + fr, col0 = u.pn * BM + wc * 32 + 8 * fq;
#pragma unroll
        for (int ai = 0; ai < 2; ++ai)
#pragma unroll
            for (int m = 0; m < 4; ++m) { bf16_t* rowp = O + (size_t)(row0 + ai * HALF + m * 16) * PW + col0;
#pragma unroll
                for (int bj = 0; bj < 2; ++bj) { const f32x4 v0 = acc[ai][bj][m][0], v1 = acc[ai][bj][m][1];
                    u32x4 w; w.x = cvtpk(v0[0], v0[1]); w.y = cvtpk(v0[2], v0[3]); w.z = cvtpk(v1[0], v1[1]); w.w = cvtpk(v1[2], v1[3]);
                    *(u32x4*)(rowp + bj * HALF) = w; } }
    }
};
struct EpiPre {
    static constexpr bool PERM = false;
    const float* X; float* O;
    __device__ __forceinline__ void operator()(const f32x4 (&acc)[2][2][4][2], const Unit& u, int wr, int wc, int fr, int fq) const {
        const int row0 = u.pm * BM + wr * 64 + fr, col0 = u.pn * BM + wc * 32 + 4 * fq;
#pragma unroll
        for (int ai = 0; ai < 2; ++ai)
#pragma unroll
            for (int m = 0; m < 4; ++m) { const size_t off = (size_t)(row0 + ai * HALF + m * 16) * D + col0;
#pragma unroll
                for (int bj = 0; bj < 2; ++bj)
#pragma unroll
                    for (int n = 0; n < 2; ++n) { const f32x4 xv = *(const f32x4*)(X + off + bj * HALF + n * 16); *(f32x4*)(O + off + bj * HALF + n * 16) = xv * DN_ALPHA + acc[ai][bj][m][n]; } }
    }
};
struct EpiSwiglu {
    static constexpr bool PERM = true;
    bf16_t* H; const float* bgu;
    __device__ __forceinline__ void operator()(const f32x4 (&acc)[2][2][4][2], const Unit& u, int wr, int wc, int fr, int fq) const {
        const int row0 = u.pm * BM + wr * 64 + fr, col0 = u.pn * BM + wc * 32 + 8 * fq;
        const float* bp = bgu + (size_t)u.e * 2048 + col0;
        f32x4 bv[2][2];
#pragma unroll
        for (int bj = 0; bj < 2; ++bj)
#pragma unroll
            for (int n = 0; n < 2; ++n) bv[bj][n] = *(const f32x4*)(bp + bj * HALF + 4 * n);
#pragma unroll
        for (int ai = 0; ai < 2; ++ai)
#pragma unroll
            for (int m = 0; m < 4; ++m) { bf16_t* rowp = H + (size_t)(row0 + ai * HALF + m * 16) * 1024 + (col0 >> 1);
#pragma unroll
                for (int bj = 0; bj < 2; ++bj) { const f32x4 v0 = acc[ai][bj][m][0] + bv[bj][0], v1 = acc[ai][bj][m][1] + bv[bj][1];
                    float hv[4];
#pragma unroll
                    for (int j = 0; j < 4; ++j) { const float g_ = j < 2 ? v0[2 * j] : v1[2 * j - 4], u_ = j < 2 ? v0[2 * j + 1] : v1[2 * j - 3];
                        const float gate = fminf(g_, 7.0f), up = fminf(fmaxf(u_, -7.0f), 7.0f);
                        hv[j] = (up + 1.0f) * gate * __builtin_amdgcn_rcpf(1.0f + __builtin_amdgcn_exp2f(-1.702f * LOG2E * gate)); }
                    u32x2 w; w.x = cvtpk(hv[0], hv[1]); w.y = cvtpk(hv[2], hv[3]);
                    *(u32x2*)(rowp + bj * (HALF / 2)) = w; } }
    }
};
struct EpiDown {
    static constexpr bool PERM = true;
    bf16_t* O; const float* bd;
    __device__ __forceinline__ void operator()(const f32x4 (&acc)[2][2][4][2], const Unit& u, int wr, int wc, int fr, int fq) const {
        const int row0 = u.pm * BM + wr * 64 + fr, col0 = u.pn * BM + wc * 32 + 8 * fq;
        const float* bp = bd + (size_t)u.e * 1024 + col0;
        f32x4 bv[2][2];
#pragma unroll
        for (int bj = 0; bj < 2; ++bj)
#pragma unroll
            for (int n = 0; n < 2; ++n) bv[bj][n] = *(const f32x4*)(bp + bj * HALF + 4 * n);
#pragma unroll
        for (int ai = 0; ai < 2; ++ai)
#pragma unroll
            for (int m = 0; m < 4; ++m) { bf16_t* rowp = O + (size_t)(row0 + ai * HALF + m * 16) * 1024 + col0;
#pragma unroll
                for (int bj = 0; bj < 2; ++bj) { const f32x4 v0 = acc[ai][bj][m][0] + bv[bj][0], v1 = acc[ai][bj][m][1] + bv[bj][1];
                    u32x4 w; w.x = cvtpk(v0[0], v0[1]); w.y = cvtpk(v0[2], v0[3]); w.z = cvtpk(v1[0], v1[1]); w.w = cvtpk(v1[2], v1[3]);
                    *(u32x4*)(rowp + bj * HALF) = w; } }
    }
};
}

namespace att {
constexpr int L_K = 0, L_V = 16384, L_CL = 32768, L_TB = 65536, L_WT = 66048, L_Q = 66560;
typedef short v4i16_t __attribute__((ext_vector_type(4)));
__device__ __forceinline__ s16x4 vtr(const LAS unsigned char* p) { return __builtin_bit_cast(s16x4, __builtin_amdgcn_ds_read_tr16_b64_v4i16((LAS v4i16_t*)p)); }
__device__ __forceinline__ int t5_bucket(int d) {
    if (d < 16) return d;
    int b = 16;
    b += (d >= 19); b += (d >= 21); b += (d >= 24); b += (d >= 27); b += (d >= 31); b += (d >= 35); b += (d >= 40); b += (d >= 46);
    b += (d >= 52); b += (d >= 59); b += (d >= 67); b += (d >= 77); b += (d >= 87); b += (d >= 99); b += (d >= 113);
    return b;
}
__device__ __forceinline__ int crow(int r, int hi) { return (r & 3) + 8 * (r >> 2) + 4 * hi; }

__device__ __forceinline__ void softmax_step(f32x16& s0, f32x16& s1, float& m, float& l, f32x16 (&o)[2], u32x4 (&pk)[4]) {
    float mx = s0[0];
#pragma unroll
    for (int r = 1; r < 16; ++r) mx = fmaxf(mx, s0[r]);
#pragma unroll
    for (int r = 0; r < 16; ++r) mx = fmaxf(mx, s1[r]);
    mx = fmaxf(mx, __shfl_xor(mx, 32));
    const float mn = fmaxf(m, mx);
    const float alpha = __builtin_amdgcn_exp2f(m - mn);
    m = mn;
    float rs = 0.f;
#pragma unroll
    for (int r = 0; r < 16; ++r) { s0[r] = __builtin_amdgcn_exp2f(s0[r] - mn); rs += s0[r]; }
#pragma unroll
    for (int r = 0; r < 16; ++r) { s1[r] = __builtin_amdgcn_exp2f(s1[r] - mn); rs += s1[r]; }
    l = l * alpha + rs;
    if (__any(alpha != 1.0f)) {
#pragma unroll
        for (int r = 0; r < 16; ++r) { o[0][r] *= alpha; o[1][r] *= alpha; }
    }
#pragma unroll
    for (int i = 0; i < 4; ++i) { pk[0][i] = cvtpk(s0[2 * i], s0[2 * i + 1]); pk[1][i] = cvtpk(s0[8 + 2 * i], s0[8 + 2 * i + 1]); pk[2][i] = cvtpk(s1[2 * i], s1[2 * i + 1]); pk[3][i] = cvtpk(s1[8 + 2 * i], s1[8 + 2 * i + 1]); }
}

template <int TYPE>
__device__ __forceinline__ void bias_mask(f32x16& s0, f32x16& s1, const LAS float* cl, const LAS float* tb, float tbfar, float scl, int kt, int qb, int qg, int qw0, int hi, unsigned long long mw) {
    const int kbase = kt * 64 + 4 * hi;
    if constexpr (TYPE == 0) {
#pragma unroll
        for (int g = 0; g < 4; ++g) { const f32x4 c0 = *(const LAS f32x4*)(cl + kbase + 8 * g), c1 = *(const LAS f32x4*)(cl + kbase + 32 + 8 * g);
#pragma unroll
            for (int j = 0; j < 4; ++j) { s0[4 * g + j] = s0[4 * g + j] * scl - c0[j]; s1[4 * g + j] = s1[4 * g + j] * scl - c1[j]; } }
        if (kt >= qb * 4) {
#pragma unroll
            for (int r = 0; r < 16; ++r) { const int kv = kbase + (r & 3) + 8 * (r >> 2); if (kv > qg) s0[r] = -INFINITY; if (kv + 32 > qg) s1[r] = -INFINITY; }
        }
    } else {
        const bool far = (kt * 64 + 63 + 113 <= qw0);
        if (far) {
#pragma unroll
            for (int r = 0; r < 16; ++r) { s0[r] = s0[r] * scl + tbfar; s1[r] = s1[r] * scl + tbfar; }
        } else {
#pragma unroll
            for (int r = 0; r < 16; ++r) {
                const int kv = kbase + (r & 3) + 8 * (r >> 2);
                const int d0 = qg - kv, d1 = d0 - 32;
                const float b0 = tb[min(max(d0, 0), 127)], b1 = tb[min(max(d1, 0), 127)];
                s0[r] = (d0 < 0) ? -INFINITY : s0[r] * scl + b0; s1[r] = (d1 < 0) ? -INFINITY : s1[r] * scl + b1;
                if ((r & 3) == 3) __builtin_amdgcn_sched_barrier(0);
            }
        }
        if constexpr (TYPE == 2) {
            const unsigned mlo = (unsigned)mw >> (4 * hi), mhi = (unsigned)(mw >> 32) >> (4 * hi);
#pragma unroll
            for (int r = 0; r < 16; ++r) { const int c = (r & 3) + 8 * (r >> 2); if (!((mlo >> c) & 1u)) s0[r] = -INFINITY; if (!((mhi >> c) & 1u)) s1[r] = -INFINITY; }
        }
    }
}
__device__ __forceinline__ void pv_step(f32x16 (&o)[2], const u32x4 (&pk)[4], const LAS unsigned char* vb) {
#pragma unroll
    for (int db = 0; db < 2; ++db) {
#pragma unroll
        for (int s = 0; s < 4; ++s) {
            const s16x4 lo = vtr(vb + db * 4096 + s * 1024), hh = vtr(vb + db * 4096 + s * 1024 + 512);
            const bf16x8 vf = (bf16x8){lo[0], lo[1], lo[2], lo[3], hh[0], hh[1], hh[2], hh[3]};
            o[db] = __builtin_amdgcn_mfma_f32_32x32x16_bf16(vf, __builtin_bit_cast(bf16x8, pk[s]), o[db], 0, 0, 0);
        }
        __builtin_amdgcn_sched_barrier(0);
    }
}

template <int TYPE>
__device__ __forceinline__ void unit(LAS unsigned char* lds, const bf16_t* __restrict__ proj, bf16_t* __restrict__ y, const unsigned long long* __restrict__ sel,
                                     const float* __restrict__ relb, float fbias, const float* __restrict__ dlam, float lam_init, const float* __restrict__ dng, int b, int h, int qb, const int tid) {
    const int lane = tid & 63, r32 = lane & 31, hi = lane >> 5;
    const int wid = __builtin_amdgcn_readfirstlane(tid >> 6);
    constexpr int QOFF = TYPE == 0 ? C_FQ : TYPE == 1 ? C_DQ : C_SQ, KOFF = TYPE == 0 ? C_FK : TYPE == 1 ? C_DK : C_SK, VOFF = TYPE == 0 ? C_FV : TYPE == 1 ? C_DV : C_SV;
    constexpr float SCL = (TYPE == 1 ? 0.17677669529663687f : 0.125f) * LOG2E;
    const size_t rowbase = (size_t)b * SEQ; const int q0 = qb * 256; const int qw0 = q0 + 32 * wid; const int qg = qw0 + r32;
    const int NT = (qb + 1) * 4;
    LAS float* cl = (LAS float*)(lds + L_CL); LAS float* tb = (LAS float*)(lds + L_TB); LAS float* wt = (LAS float*)(lds + L_WT);
    const bf16_t* kg; const bf16_t* vg;
    { const int row = 8 * wid + (lane >> 3), c = (lane & 7) ^ ((row >> 1) & 7); kg = proj + (rowbase + row) * PW + KOFF + h * 64 + c * 8; }
    { const int row = 16 * (wid & 3) + (lane >> 2), c = (wid >> 2) * 4 + (lane & 3); vg = proj + (rowbase + row) * PW + VOFF + h * 64 + c * 8; }
#define ATT_DMA(kt_, buf_) do { __builtin_amdgcn_global_load_lds((const unsigned*)(kg + (size_t)(kt_) * 64 * PW), (LAS unsigned*)(lds + L_K + (buf_) * 8192 + wid * 1024), 16, 0, 0); \
                                __builtin_amdgcn_global_load_lds((const unsigned*)(vg + (size_t)(kt_) * 64 * PW), (LAS unsigned*)(lds + L_V + (buf_) * 8192 + wid * 1024), 16, 0, 0); } while (0)
    ATT_DMA(0, 0);
    bf16x8 qf[4];
    { const bf16_t* qp = proj + (rowbase + qg) * PW + QOFF + h * 64 + 8 * hi;
#pragma unroll
      for (int s = 0; s < 4; ++s) { qf[s] = *(const bf16x8*)(qp + 16 * s); if constexpr (TYPE == 1) *(LAS bf16x8*)(lds + L_Q + wid * 4096 + s * 1024 + lane * 16) = qf[s]; } }
    float lam = 0.f;
    if constexpr (TYPE == 0) {
        const int n = (qb + 1) * 256;
        float v[16]; float run = 0.f;
        const bf16_t* fp = proj + (rowbase + (size_t)tid * 16) * PW + C_FF + h;
#pragma unroll
        for (int i = 0; i < 16; ++i) {
            float ls = 0.f;
            if (tid * 16 + i < n) { const float x = bf2f(fp[(size_t)i * PW]) + fbias; ls = (x >= 0.f) ? -log1pf(__expf(-x)) : (x - log1pf(__expf(x))); }
            run += ls; v[i] = run;
        }
        float incl = run;
#pragma unroll
        for (int off = 1; off < 64; off <<= 1) { const float yv = __shfl_up(incl, off); if (lane >= off) incl += yv; }
        if (lane == 63) wt[wid] = incl;
        __syncthreads();
        float woff = 0.f;
        for (int w = 0; w < wid; ++w) woff += wt[w];
        const float base = incl - run + woff;
#pragma unroll
        for (int i = 0; i < 16; ++i) cl[tid * 16 + i] = (v[i] + base) * LOG2E;
    } else {
        if (tid < 128) tb[tid] = relb[t5_bucket(tid) * 8 + (TYPE == 1 ? h : 4 + h)] * LOG2E;
        if constexpr (TYPE == 1) {
            float a = 0.f, c = 0.f;
            if (lane < 32) { a = dlam[lane] * dlam[32 + lane]; c = dlam[64 + lane] * dlam[96 + lane]; }
            a = wave_sum(a); c = wave_sum(c);
            lam = __expf(a) - __expf(c) + lam_init;
        }
    }
    VM_WAIT();
    __syncthreads();
    const float tbfar = (TYPE == 0) ? 0.f : tb[127];
    const int xr = (r32 >> 1) & 7;
    int koff[4];
#pragma unroll
    for (int s = 0; s < 4; ++s) koff[s] = r32 * 128 + (((2 * s + hi) ^ xr) << 4);
    const int vrd = ((lane >> 4) & 1) * 32 + (lane & 3) * 8 + (4 * hi + ((lane & 15) >> 2)) * 64;
    float mA = -1e30f, lA = 0.f, mB = -1e30f, lB = 0.f;
    f32x16 oA[2], oB[2];
    oA[0] = f32x16{}; oA[1] = f32x16{}; oB[0] = f32x16{}; oB[1] = f32x16{};
    const unsigned long long* selp = sel + (rowbase + qg) * 128;
    for (int kt = 0; kt < NT; ++kt) {
        const int buf = kt & 1;
        if (kt + 1 < NT) ATT_DMA(kt + 1, buf ^ 1);
        unsigned long long mw = 0ull;
        if constexpr (TYPE == 2) mw = selp[kt];
        const LAS unsigned char* kb = lds + L_K + buf * 8192; const LAS unsigned char* vb = lds + L_V + buf * 8192 + vrd;
        {
            f32x16 s0 = f32x16{}, s1 = f32x16{};
#pragma unroll
            for (int s = 0; s < (TYPE == 1 ? 2 : 4); ++s) {
                const bf16x8 k0 = *(const LAS bf16x8*)(kb + koff[s]), k1 = *(const LAS bf16x8*)(kb + 4096 + koff[s]);
                const bf16x8 qv = (TYPE == 1) ? *(const LAS bf16x8*)(lds + L_Q + wid * 4096 + s * 1024 + lane * 16) : qf[s];
                s0 = __builtin_amdgcn_mfma_f32_32x32x16_bf16(k0, qv, s0, 0, 0, 0); s1 = __builtin_amdgcn_mfma_f32_32x32x16_bf16(k1, qv, s1, 0, 0, 0);
            }
            __builtin_amdgcn_sched_barrier(0);
            bias_mask<TYPE>(s0, s1, cl, tb, tbfar, SCL, kt, qb, qg, qw0, hi, mw);
            __builtin_amdgcn_sched_barrier(0);
            u32x4 pk[4];
            softmax_step(s0, s1, mA, lA, oA, pk);
            __builtin_amdgcn_sched_barrier(0);
            pv_step(oA, pk, vb);
        }
        if constexpr (TYPE == 1) {
            __builtin_amdgcn_sched_barrier(0);
            f32x16 s0 = f32x16{}, s1 = f32x16{};
#pragma unroll
            for (int s = 2; s < 4; ++s) {
                const bf16x8 k0 = *(const LAS bf16x8*)(kb + koff[s]), k1 = *(const LAS bf16x8*)(kb + 4096 + koff[s]);
                const bf16x8 qv = *(const LAS bf16x8*)(lds + L_Q + wid * 4096 + s * 1024 + lane * 16);
                s0 = __builtin_amdgcn_mfma_f32_32x32x16_bf16(k0, qv, s0, 0, 0, 0); s1 = __builtin_amdgcn_mfma_f32_32x32x16_bf16(k1, qv, s1, 0, 0, 0);
            }
            __builtin_amdgcn_sched_barrier(0);
            bias_mask<TYPE>(s0, s1, cl, tb, tbfar, SCL, kt, qb, qg, qw0, hi, mw);
            __builtin_amdgcn_sched_barrier(0);
            u32x4 pk[4];
            softmax_step(s0, s1, mB, lB, oB, pk);
            __builtin_amdgcn_sched_barrier(0);
            pv_step(oB, pk, vb);
        }
        VM_WAIT();
        __syncthreads();
    }
#undef ATT_DMA
    lA += __shfl_xor(lA, 32); const float iA = 1.0f / lA;
    bf16_t* yp = y + (rowbase + qg) * 1024 + TYPE * 256 + h * 64 + 4 * hi;
    if constexpr (TYPE == 1) {
        lB += __shfl_xor(lB, 32); const float iB = lam / lB;
        float ss = 0.f;
#pragma unroll
        for (int db = 0; db < 2; ++db)
#pragma unroll
            for (int r = 0; r < 16; ++r) { const float v = oA[db][r] * iA - oB[db][r] * iB; oA[db][r] = v; ss += v * v; }
        ss += __shfl_xor(ss, 32);
        const float rn = rsqrtf(ss * (1.0f / 64.0f) + LN_EPS) * (1.0f - lam_init);
#pragma unroll
        for (int db = 0; db < 2; ++db)
#pragma unroll
            for (int g = 0; g < 4; ++g) { const f32x4 gv = *(const f32x4*)(dng + db * 32 + 8 * g + 4 * hi);
                u32x2 w; w.x = cvtpk(oA[db][4 * g] * rn * gv[0], oA[db][4 * g + 1] * rn * gv[1]); w.y = cvtpk(oA[db][4 * g + 2] * rn * gv[2], oA[db][4 * g + 3] * rn * gv[3]);
                *(u32x2*)(yp + db * 32 + 8 * g) = w; }
    } else {
#pragma unroll
        for (int db = 0; db < 2; ++db)
#pragma unroll
            for (int g = 0; g < 4; ++g) { u32x2 w; w.x = cvtpk(oA[db][4 * g] * iA, oA[db][4 * g + 1] * iA); w.y = cvtpk(oA[db][4 * g + 2] * iA, oA[db][4 * g + 3] * iA);
                *(u32x2*)(yp + db * 32 + 8 * g) = w; }
    }
    __syncthreads();
}
}

namespace idx {
__device__ __forceinline__ unsigned f2key(float v) { v = v + 0.0f; const unsigned x = __float_as_uint(v); return x ^ ((unsigned)((int)x >> 31) | 0x80000000u); }
template <bool TAIL>
__device__ __forceinline__ void topk_query(const float* __restrict__ srow, int q, LAS unsigned* hist, unsigned long long* __restrict__ selrow, int lane) {
    constexpr int NR = 64;
    unsigned u[NR];
    const __amdgpu_buffer_rsrc_t rsrc = __builtin_amdgcn_make_buffer_rsrc((void*)srow, 0, 8192 * 4, 0x00020000);
#pragma unroll
    for (int j = 0; j < NR; ++j) {
        const int k = j * 64 + lane;
        const float v = __builtin_bit_cast(float, __builtin_amdgcn_raw_buffer_load_b32(rsrc, lane * 4, j * 256, 0));
        u[j] = f2key(v) & (unsigned)((k - q - 1) >> 31);
        if ((j & 7) == 7) __builtin_amdgcn_sched_barrier(0);
    }
    const int ntail = TAIL ? ((q >> 6) + 1 - 64) : 0;
    unsigned prefix = 0u, need = 256u;
    for (int pass = 0; pass < 4; ++pass) {
        const int shift = 24 - 8 * pass;
#pragma unroll
        for (int i = 0; i < 9; ++i) *(LAS u32x4*)(hist + (i * 64 + lane) * 4) = (u32x4){0u, 0u, 0u, 0u};
        LDS_WAIT();
        const unsigned pshift = (unsigned)(shift + 8) & 31u; const unsigned pmask = (pass == 0) ? 0u : 0xffffffffu;
        const unsigned cpy = (unsigned)(lane & 7), dummy = 2048u + (unsigned)lane;
#pragma unroll
        for (int j = 0; j < NR; ++j) {
            const unsigned key = u[j];
            const unsigned diff = ((key >> pshift) ^ prefix) & pmask;
            const unsigned real = ((key >> shift) & 255u) * 8u + cpy;
            const unsigned slot = dummy + (1u - min(diff, 1u)) * (real - dummy);
            __hip_atomic_fetch_add(hist + slot, 1u, __ATOMIC_RELAXED, __HIP_MEMORY_SCOPE_WORKGROUP);
            if ((j & 7) == 7) __builtin_amdgcn_sched_barrier(0);
        }
        if constexpr (TAIL) {
#pragma unroll 2
            for (int j = 0; j < ntail; ++j) {
                const int k = 4096 + j * 64 + lane;
                const float v = __builtin_bit_cast(float, __builtin_amdgcn_raw_buffer_load_b32(rsrc, lane * 4, 16384 + j * 256, 0));
                const unsigned key = f2key(v) & (unsigned)((k - q - 1) >> 31);
                const unsigned diff = ((key >> pshift) ^ prefix) & pmask;
                const unsigned real = ((key >> shift) & 255u) * 8u + cpy;
                const unsigned slot = dummy + (1u - min(diff, 1u)) * (real - dummy);
                __hip_atomic_fetch_add(hist + slot, 1u, __ATOMIC_RELAXED, __HIP_MEMORY_SCOPE_WORKGROUP);
            }
        }
        LDS_WAIT();
        unsigned c[4];
#pragma unroll
        for (int bq = 0; bq < 4; ++bq) { const u32x4 a = *(const LAS u32x4*)(hist + (4 * lane + bq) * 8), d = *(const LAS u32x4*)(hist + (4 * lane + bq) * 8 + 4); c[bq] = (a[0] + a[1]) + (a[2] + a[3]) + (d[0] + d[1]) + (d[2] + d[3]); }
        const unsigned tot = (c[0] + c[1]) + (c[2] + c[3]);
        unsigned incl = tot;
#pragma unroll
        for (int off = 1; off < 64; off <<= 1) { const unsigned yv = __shfl_down(incl, off); if (lane + off < 64) incl += yv; }
        const unsigned a3 = incl - tot, a2 = a3 + c[3], a1 = a2 + c[2], a0 = a1 + c[1];
        int dsel = -1; unsigned ab = 0u;
        if (a3 < need && a3 + c[3] >= need) { dsel = 4 * lane + 3; ab = a3; }
        else if (a2 < need && a2 + c[2] >= need) { dsel = 4 * lane + 2; ab = a2; }
        else if (a1 < need && a1 + c[1] >= need) { dsel = 4 * lane + 1; ab = a1; }
        else if (a0 < need && a0 + c[0] >= need) { dsel = 4 * lane + 0; ab = a0; }
        const unsigned long long fm = __ballot(dsel >= 0);
        const int src = fm ? (__ffsll((long long)fm) - 1) : 0;
        const unsigned dd = (unsigned)__shfl(dsel, src), abb = (unsigned)__shfl((int)ab, src);
        need -= abb; prefix = (prefix << 8) | (dd & 255u);
        LDS_WAIT();
    }
    unsigned run_eq = 0u;
    const unsigned long long ltmask = (lane == 0) ? 0ull : (~0ull >> (64 - lane));
    LAS unsigned long long* wout = (LAS unsigned long long*)hist;
#pragma unroll
    for (int j = 0; j < NR; ++j) {
        const unsigned key = u[j];
        const bool eq = key == prefix;
        const unsigned long long em = __ballot(eq);
        const unsigned rank = run_eq + (unsigned)__popcll(em & ltmask);
        const bool sl = (key > prefix) || (eq && rank < need);
        run_eq += (unsigned)__popcll(em);
        const unsigned long long sm = __ballot(sl);
        if (lane == 0) wout[j] = sm;
        if ((j & 3) == 3) __builtin_amdgcn_sched_barrier(0);
    }
    if constexpr (TAIL) {
        for (int j = 0; j < 64; ++j) {
            unsigned long long sm = 0ull;
            if (j < ntail) {
                const int k = 4096 + j * 64 + lane;
                const float v = __builtin_bit_cast(float, __builtin_amdgcn_raw_buffer_load_b32(rsrc, lane * 4, 16384 + j * 256, 0));
                const unsigned key = f2key(v) & (unsigned)((k - q - 1) >> 31);
                const bool eq = key == prefix;
                const unsigned long long em = __ballot(eq);
                const unsigned rank = run_eq + (unsigned)__popcll(em & ltmask);
                const bool sl = (key > prefix) || (eq && rank < need);
                run_eq += (unsigned)__popcll(em);
                sm = __ballot(sl);
            }
            if (lane == 0) wout[64 + j] = sm;
        }
    }
    LDS_WAIT();
    selrow[lane] = wout[lane]; selrow[64 + lane] = TAIL ? wout[64 + lane] : 0ull;
    LDS_WAIT();
}

__device__ __forceinline__ void tile(LAS unsigned char* lds, const bf16_t* __restrict__ proj, float* __restrict__ scr, unsigned long long* __restrict__ sel, int b, int jt, const int tid) {
    const int lane = tid & 63, r32 = lane & 31, hi = lane >> 5;
    const int wid = __builtin_amdgcn_readfirstlane(tid >> 6);
    const size_t rowbase = (size_t)b * SEQ; const int q0 = jt * 32; const int g = wid & 3, p = wid >> 2;
    bf16x8 af[4];
    { const bf16_t* ap = proj + (rowbase + q0 + 8 * g + (r32 >> 2)) * PW + C_IQ + (r32 & 3) * 64 + 8 * hi;
#pragma unroll
      for (int s = 0; s < 4; ++s) af[s] = *(const bf16x8*)(ap + 16 * s); }
    float cw[16];
#pragma unroll
    for (int r = 0; r < 16; ++r) cw[r] = bf2f(proj[(rowbase + q0 + 8 * g + 2 * (r >> 2) + hi) * PW + C_IW + (r & 3)]) * 0.0625f;
    const int nkt = jt + 1;
    for (int kt = p; kt < nkt; kt += 2) {
        const bf16_t* bp = proj + (rowbase + kt * 32 + r32) * PW + C_IK + 8 * hi;
        bf16x8 bfr[4];
#pragma unroll
        for (int s = 0; s < 4; ++s) bfr[s] = *(const bf16x8*)(bp + 16 * s);
        f32x16 acc = f32x16{};
#pragma unroll
        for (int s = 0; s < 4; ++s) acc = __builtin_amdgcn_mfma_f32_32x32x16_bf16(af[s], bfr[s], acc, 0, 0, 0);
#pragma unroll
        for (int qi = 0; qi < 4; ++qi) {
            float sc = 0.f;
#pragma unroll
            for (int hh = 0; hh < 4; ++hh) sc += cw[4 * qi + hh] * fmaxf(acc[4 * qi + hh], 0.f);
            scr[(size_t)(8 * g + 2 * qi + hi) * 8192 + kt * 32 + r32] = sc;
        }
    }
    __syncthreads();
    LAS unsigned* hist = (LAS unsigned*)lds + wid * 2304;
    if (q0 < 256) {
        for (int i = 0; i < 4; ++i) {
            const int q = q0 + 4 * wid + i; unsigned long long* selrow = sel + (rowbase + q) * 128;
            const int nb0 = q + 1 - 64 * lane;
            selrow[lane] = nb0 >= 64 ? ~0ull : (nb0 <= 0 ? 0ull : ((1ull << nb0) - 1ull)); selrow[64 + lane] = 0ull;
        }
    } else if (q0 < 4096) {
#pragma unroll 1
        for (int i = 0; i < 4; ++i) { const int ql = 4 * wid + i, q = q0 + ql; topk_query<false>(scr + (size_t)ql * 8192, q, hist, sel + (rowbase + q) * 128, lane); }
    } else {
#pragma unroll 1
        for (int i = 0; i < 4; ++i) { const int ql = 4 * wid + i, q = q0 + ql; topk_query<true>(scr + (size_t)ql * 8192, q, hist, sel + (rowbase + q) * 128, lane); }
    }
    __syncthreads();
}
}

__device__ __forceinline__ void conv_tile(LAS unsigned char* lds, const bf16_t* __restrict__ proj, bf16_t* __restrict__ y, const float* __restrict__ cwt, const float* __restrict__ cb,
                                          const float* __restrict__ lg, const float* __restrict__ lb, int b, int t0, const int tid) {
    const int lane = tid & 63; const int wid = __builtin_amdgcn_readfirstlane(tid >> 6);
    LAS float* hb = (LAS float*)lds;
    LAS float* ob = (LAS float*)(lds + 65536);
    const size_t rowbase = (size_t)b * SEQ;
    for (int idx = tid; idx < 62 * 256; idx += NTHR) {
        const int rr = idx >> 8, c = idx & 255, t = t0 - 30 + rr;
        float hv = 0.f;
        if (t >= 0) { const bf16_t* p = proj + (rowbase + t) * PW + C_CU + c; hv = bf2f(p[0]) * sigmoidf_(bf2f(p[256])); }
        hb[idx] = hv;
    }
    __syncthreads();
    { const int c = tid & 255, half = tid >> 8;
      float w[31];
#pragma unroll
      for (int j = 0; j < 31; ++j) w[j] = cwt[j * 256 + c];
      const float bias = cb[c];
      for (int tt = half * 16; tt < half * 16 + 16; ++tt) {
          float a = bias;
#pragma unroll
          for (int j = 0; j < 31; ++j) a += w[j] * hb[(tt + j) * 256 + c];
          ob[tt * 256 + c] = a;
      } }
    __syncthreads();
    for (int i = 0; i < 4; ++i) {
        const int tt = wid * 4 + i;
        const f32x4 v = *(const LAS f32x4*)(ob + tt * 256 + lane * 4);
        const float mean = wave_sum((v[0] + v[1]) + (v[2] + v[3])) * (1.0f / 256.0f);
        const f32x4 d = v - mean;
        const float var = wave_sum((d[0] * d[0] + d[1] * d[1]) + (d[2] * d[2] + d[3] * d[3])) * (1.0f / 256.0f);
        const float rstd = rsqrtf(var + LN_EPS);
        const f32x4 gv = *(const f32x4*)(lg + lane * 4), bv = *(const f32x4*)(lb + lane * 4);
        float o[4];
#pragma unroll
        for (int j = 0; j < 4; ++j) { const float z = d[j] * rstd * gv[j] + bv[j]; o[j] = z * sigmoidf_(z); }
        u32x2 w2; w2.x = cvtpk(o[0], o[1]); w2.y = cvtpk(o[2], o[3]);
        *(u32x2*)(y + (rowbase + t0 + tt) * 1024 + 768 + lane * 4) = w2;
    }
    __syncthreads();
}

__device__ __forceinline__ void cvt_item(const float* __restrict__ src, int ldn, int ncol, bool valid, bf16_t* __restrict__ drow, int k0) {
    float v[64];
#pragma unroll
    for (int j = 0; j < 64; ++j) v[j] = valid ? src[(size_t)(k0 + j) * ldn + ncol] : 0.f;
#pragma unroll
    for (int c = 0; c < 8; ++c) { u32x4 w; w.x = cvtpk(v[8 * c], v[8 * c + 1]); w.y = cvtpk(v[8 * c + 2], v[8 * c + 3]); w.z = cvtpk(v[8 * c + 4], v[8 * c + 5]); w.w = cvtpk(v[8 * c + 6], v[8 * c + 7]);
        *(u32x4*)(drow + k0 + 8 * c) = w; }
}
__device__ __forceinline__ int win_src_col(int n) {
    if (n < 768) return n;
    if (n < 2624) return n + 4;
    if (n < 3136) return n + 8;
    if (n < 3140) return 768 + (n - 3136);
    if (n < 3144) return 2628 + (n - 3140);
    return -1;
}

#ifndef PH_MASK
#define PH_MASK 0xFFFF
#endif
#define PHASE_ON(n) ((PH_MASK >> (n)) & 1)
struct Args { const float* in[21]; float* out; unsigned char* ws; };

__device__ __forceinline__ int q_fetch(unsigned* ctr, volatile LAS int* bc, int tid) {
    __syncthreads();
    if (tid == 0) *bc = (int)__hip_atomic_fetch_add(ctr, 1u, __ATOMIC_RELAXED, __HIP_MEMORY_SCOPE_AGENT);
    __syncthreads();
    return __builtin_amdgcn_readfirstlane(*bc);
}

typedef const __attribute__((address_space(4))) Args* ArgsP;
#define PHASE_PTRS() ArgsP ap_ = (ArgsP)__builtin_amdgcn_kernarg_segment_ptr(); asm volatile("" : "+s"(ap_)); unsigned char* ws = ap_->ws; unsigned* ctl = (unsigned*)(ws + WS_CTL); (void)ctl; int tid = wid0 * 64 + lane_id_(); asm volatile("" : "+v"(tid)); const int lane = tid & 63; const int wid = __builtin_amdgcn_readfirstlane(tid >> 6); (void)lane; (void)wid
#define IN(i) (ap_->in[i])

template <int layer>
__device__ __forceinline__ void run_layer(LAS unsigned char* lds, const XcdBarrier& bar, volatile LAS int* qbc, const int G, const int bid, const int wid0) {
        const float lam_init = (layer == 0) ? 0.2f : (layer == 1) ? 0.35550906759096934f : (layer == 2) ? 0.4707130183435842f : 0.5560582041556406f;
#if PHASE_ON(1)
    asm volatile("; PHASE_MARK 1");
        {
            PHASE_PTRS();
            pg8::DenseSched S; S.init((const bf16_t*)(ws + WS_XB), (const bf16_t*)(ws + WS_WIN) + (size_t)layer * PW * 1024, T, PW, G, bid);
            pg8::EpiProj E{(bf16_t*)(ws + WS_PROJ)};
            pg8::gemm_phase<pg8::EpiProj, pg8::DenseSched, true>(lds, S, E, tid);
        }
#endif
        xcd_barrier(bar, wid0);
#if PHASE_ON(2)
    asm volatile("; PHASE_MARK 2");
        {
            PHASE_PTRS();
            const bf16_t* PROJ = (const bf16_t*)(ws + WS_PROJ); bf16_t* Y = (bf16_t*)(ws + WS_Y); unsigned long long* SEL = (unsigned long long*)(ws + WS_SEL); float* SCR = (float*)(ws + WS_SCR) + (size_t)bid * 32 * 8192;
            const float* conv_w = IN(6); const float* conv_b = IN(7); const float* conv_ln_g = IN(8); const float* conv_ln_b = IN(9);
            for (int u2 = bid * 2; u2 < 512; u2 += (u2 & 1) ? (2 * G - 1) : 1) { const int u = u2 >> 1, b = u >> 7, j = u & 127; idx::tile(lds, PROJ, SCR, SEL, b, (u2 & 1) ? 255 - j : j, tid); }
            for (int u = bid; u < T / 32; u += G) { const int b = u / (SEQ / 32), t0 = (u % (SEQ / 32)) * 32;
                conv_tile(lds, PROJ, Y, conv_w + (size_t)layer * 31 * 256, conv_b + layer * 256, conv_ln_g + layer * 256, conv_ln_b + layer * 256, b, t0, tid); }
        }
#endif
        xcd_barrier(bar, wid0);
#if PHASE_ON(3)
    asm volatile("; PHASE_MARK 3");
        {
            PHASE_PTRS();
            const bf16_t* PROJ = (const bf16_t*)(ws + WS_PROJ); bf16_t* Y = (bf16_t*)(ws + WS_Y); const unsigned long long* SEL = (const unsigned long long*)(ws + WS_SEL);
            const float* rel_bias = IN(1); const float* forget_b = IN(3); const float* diff_lambda = IN(4); const float* diff_norm_g = IN(5);
#ifndef ATT_MASK
#define ATT_MASK 7
#endif
            if (ATT_MASK & 1) for (;;) { const int u = q_fetch(ctl + CW_Q + (layer * 8 + 0) * 64, qbc, tid); if (u >= 256) break; const int qb = 31 - (u >> 3), b = (u >> 2) & 1, h = u & 3;
                att::unit<1>(lds, PROJ, Y, SEL, rel_bias, 0.f, diff_lambda + layer * 128, lam_init, diff_norm_g + layer * 64, b, h, qb, tid); }
            if (ATT_MASK & 2) for (;;) { const int u = q_fetch(ctl + CW_Q + (layer * 8 + 1) * 64, qbc, tid); if (u >= 256) break; const int qb = 31 - (u >> 3), b = (u >> 2) & 1, h = u & 3;
                att::unit<0>(lds, PROJ, Y, SEL, rel_bias, forget_b[layer * 4 + h], nullptr, 0.f, nullptr, b, h, qb, tid); }
            if (ATT_MASK & 4) for (;;) { const int u = q_fetch(ctl + CW_Q + (layer * 8 + 2) * 64, qbc, tid); if (u >= 256) break; const int qb = 31 - (u >> 3), b = (u >> 2) & 1, h = u & 3;
                att::unit<2>(lds, PROJ, Y, SEL, rel_bias, 0.f, nullptr, 0.f, nullptr, b, h, qb, tid); }
        }
#endif
        xcd_barrier(bar, wid0);
#if PHASE_ON(4)
    asm volatile("; PHASE_MARK 4");
        {
            PHASE_PTRS();
            pg8::DenseSched S; S.init((const bf16_t*)(ws + WS_Y), (const bf16_t*)(ws + WS_WOUT) + (size_t)layer * 1024 * 1024, T, 1024, G, bid);
            pg8::EpiPre E{(layer == 0) ? IN(0) : (const float*)(ws + WS_XF), (float*)(ws + WS_PRE)};
            pg8::gemm_phase<pg8::EpiPre, pg8::DenseSched, true>(lds, S, E, tid);
        }
#endif
        xcd_barrier(bar, wid0);
#if PHASE_ON(5)
    asm volatile("; PHASE_MARK 5");
        {
            PHASE_PTRS();
            const float* ln1_g = IN(11); const float* ln1_b = IN(12); const float* router_b = IN(14);
            const bf16_t* RWT = (const bf16_t*)(ws + WS_RWT); const float* PRE = (const float*)(ws + WS_PRE); float* X1F = (float*)(ws + WS_X1F); bf16_t* X1B = (bf16_t*)(ws + WS_X1B);
            int* TOK = (int*)(ws + WS_TOK); int* PE = (int*)(ws + WS_PE); int* PS = PE + T * 4; float* PG = (float*)(PS + T * 4);
            LAS float* red = (LAS float*)lds;
            LAS float* part = (LAS float*)(lds + 1024);
            LAS int* lcnt = (LAS int*)(lds + 1024 + 32768);
            LAS int* lbase = lcnt + 32;
            LAS int* pe_ = lbase + 32;
            LAS int* pl_ = pe_ + 128;
            LAS float* pg_ = (LAS float*)(pl_ + 128);
            const int r32 = lane & 31, hi = lane >> 5;
            const float* g1 = ln1_g + layer * 1024; const float* b1 = ln1_b + layer * 1024;
            const bf16_t* rwh = RWT + (size_t)(layer * 2 + 0) * 32 * 1024; const bf16_t* rwl = RWT + (size_t)(layer * 2 + 1) * 32 * 1024;
            unsigned* ecnt = ctl + CW_ECNT + layer * 64;
            for (int u = bid; u < T / 32; u += G) {
                const int r0 = u * 32; const int kb0 = 128 * wid + 8 * hi;
                const float* pr = PRE + (size_t)(r0 + r32) * 1024 + kb0;
                f32x4 v[8][2];
                float s = 0.f;
#pragma unroll
                for (int si = 0; si < 8; ++si) { v[si][0] = *(const f32x4*)(pr + 16 * si); v[si][1] = *(const f32x4*)(pr + 16 * si + 4);
                    s += (v[si][0][0] + v[si][0][1]) + (v[si][0][2] + v[si][0][3]) + (v[si][1][0] + v[si][1][1]) + (v[si][1][2] + v[si][1][3]); }
                s += __shfl_xor(s, 32);
                if (tid < 32) lcnt[tid] = 0;
                if (hi == 0) red[wid * 32 + r32] = s;
                __syncthreads();
                float mean = 0.f;
#pragma unroll
                for (int w = 0; w < 8; ++w) mean += red[w * 32 + r32];
                mean *= (1.0f / 1024.0f);
                float s2 = 0.f;
#pragma unroll
                for (int si = 0; si < 8; ++si)
#pragma unroll
                    for (int j = 0; j < 2; ++j) { v[si][j] = v[si][j] - mean; s2 += (v[si][j][0] * v[si][j][0] + v[si][j][1] * v[si][j][1]) + (v[si][j][2] * v[si][j][2] + v[si][j][3] * v[si][j][3]); }
                s2 += __shfl_xor(s2, 32);
                __syncthreads();
                if (hi == 0) red[wid * 32 + r32] = s2;
                __syncthreads();
                float var = 0.f;
#pragma unroll
                for (int w = 0; w < 8; ++w) var += red[w * 32 + r32];
                const float rstd = rsqrtf(var * (1.0f / 1024.0f) + LN_EPS);
                f32x16 acc = f32x16{};
                float* xo = X1F + (size_t)(r0 + r32) * 1024 + kb0; bf16_t* xbo = X1B + (size_t)(r0 + r32) * 1024 + kb0;
#pragma unroll
                for (int si = 0; si < 8; ++si) {
                    u32x4 ah, al;
#pragma unroll
                    for (int j = 0; j < 2; ++j) {
                        const f32x4 gv = *(const f32x4*)(g1 + kb0 + 16 * si + 4 * j), bv = *(const f32x4*)(b1 + kb0 + 16 * si + 4 * j);
                        const f32x4 xv = v[si][j] * rstd * gv + bv;
                        *(f32x4*)(xo + 16 * si + 4 * j) = xv;
                        const unsigned h0 = cvtpk(xv[0], xv[1]), h1 = cvtpk(xv[2], xv[3]);
                        const unsigned l0 = cvtpk(xv[0] - __uint_as_float(h0 << 16), xv[1] - __uint_as_float(h0 & 0xffff0000u)), l1 = cvtpk(xv[2] - __uint_as_float(h1 << 16), xv[3] - __uint_as_float(h1 & 0xffff0000u));
                        ah[2 * j] = h0; ah[2 * j + 1] = h1; al[2 * j] = l0; al[2 * j + 1] = l1;
                    }
                    *(u32x4*)(xbo + 16 * si) = ah;
                    const bf16x8 bh = *(const bf16x8*)(rwh + (size_t)r32 * 1024 + kb0 + 16 * si), bl = *(const bf16x8*)(rwl + (size_t)r32 * 1024 + kb0 + 16 * si);
                    acc = __builtin_amdgcn_mfma_f32_32x32x16_bf16(__builtin_bit_cast(bf16x8, ah), bh, acc, 0, 0, 0);
                    acc = __builtin_amdgcn_mfma_f32_32x32x16_bf16(__builtin_bit_cast(bf16x8, ah), bl, acc, 0, 0, 0);
                    acc = __builtin_amdgcn_mfma_f32_32x32x16_bf16(__builtin_bit_cast(bf16x8, al), bh, acc, 0, 0, 0);
                }
#pragma unroll
                for (int r = 0; r < 16; ++r) part[(wid * 32 + att::crow(r, hi)) * 32 + r32] = acc[r];
                __syncthreads();
#pragma unroll
                for (int rnd = 0; rnd < 2; ++rnd) {
                    const int tk = 4 * wid + 2 * rnd + hi;
                    float lg_ = router_b[layer * 32 + r32];
#pragma unroll
                    for (int w = 0; w < 8; ++w) lg_ += part[(w * 32 + tk) * 32 + r32];
                    float tv[4]; int te[4];
#pragma unroll
                    for (int k = 0; k < 4; ++k) {
                        const unsigned xb_ = __float_as_uint(lg_); const unsigned key = (xb_ & 0x80000000u) ? ~xb_ : (xb_ | 0x80000000u);
                        unsigned long long kk = ((unsigned long long)key << 32) | (unsigned)(31 - r32);
#pragma unroll
                        for (int o = 1; o < 32; o <<= 1) { const unsigned long long ot = __shfl_xor(kk, o); kk = ot > kk ? ot : kk; }
                        const int ew = 31 - (int)(kk & 31u);
                        const unsigned kx = (unsigned)(kk >> 32); const unsigned vb_ = (kx & 0x80000000u) ? (kx & 0x7fffffffu) : ~kx;
                        tv[k] = __uint_as_float(vb_); te[k] = ew;
                        if (r32 == ew) lg_ = -INFINITY;
                    }
                    const float e1 = __expf(tv[1] - tv[0]), e2 = __expf(tv[2] - tv[0]), e3 = __expf(tv[3] - tv[0]);
                    const float inv = 1.0f / (1.0f + e1 + e2 + e3);
                    if (r32 < 4) {
                        const int ee = r32 == 0 ? te[0] : r32 == 1 ? te[1] : r32 == 2 ? te[2] : te[3];
                        const float gg = (r32 == 0 ? 1.0f : r32 == 1 ? e1 : r32 == 2 ? e2 : e3) * inv;
                        const int lr = __hip_atomic_fetch_add(lcnt + ee, 1, __ATOMIC_RELAXED, __HIP_MEMORY_SCOPE_WORKGROUP);
                        pe_[tk * 4 + r32] = ee; pl_[tk * 4 + r32] = lr; pg_[tk * 4 + r32] = gg;
                    }
                }
                __syncthreads();
                if (tid < 32) { const int n = lcnt[tid]; lbase[tid] = n > 0 ? (int)__hip_atomic_fetch_add(ecnt + tid, (unsigned)n, __ATOMIC_RELAXED, __HIP_MEMORY_SCOPE_AGENT) : 0; }
                __syncthreads();
                if (tid < 128) { const int ee = pe_[tid], slot = lbase[ee] + pl_[tid], tok = r0 + (tid >> 2);
                    TOK[(size_t)ee * ECAP + slot] = tok; PE[tok * 4 + (tid & 3)] = ee; PS[tok * 4 + (tid & 3)] = slot; PG[tok * 4 + (tid & 3)] = pg_[tid]; }
                __syncthreads();
            }
        }
#endif
        xcd_barrier(bar, wid0);
        LAS int* t_texp = (LAS int*)(lds + LDS_TAB);
        LAS int* t_tstart = t_texp + MAXTILES;
        LAS int* t_cnt = t_tstart + 36;
        {
            PHASE_PTRS();
            unsigned* ecnt = ctl + CW_ECNT + layer * 64;
            if (tid < 64) {
                const int n = (lane < NE) ? (int)__hip_atomic_load(ecnt + (lane & 31), __ATOMIC_RELAXED, __HIP_MEMORY_SCOPE_AGENT) : 0;
                const int nt_ = (n + 255) >> 8; int incl = nt_;
#pragma unroll
                for (int off = 1; off < 64; off <<= 1) { const int yv = __shfl_up(incl, off); if (lane >= off) incl += yv; }
                const int st_ = incl - nt_;
                if (lane < NE) { t_cnt[lane] = n; t_tstart[lane] = st_;
#pragma unroll 1
                    for (int j = 0; j < nt_; ++j) t_texp[st_ + j] = lane; }
                if (lane == NE) t_tstart[NE] = st_;
            }
            __syncthreads();
        }
        const int ntiles = __builtin_amdgcn_readfirstlane(t_tstart[NE]);
        pg8::MoeTabs tabs{t_texp, t_tstart, t_cnt, ntiles};
#if PHASE_ON(6)
    asm volatile("; PHASE_MARK 6");
        {
            PHASE_PTRS();
            pg8::MoeSched<true, 8> S{(const bf16_t*)(ws + WS_X1B), (const bf16_t*)(ws + WS_WGU) + (size_t)layer * NE * 2048 * 1024, (const int*)(ws + WS_TOK), tabs, G, bid};
            pg8::EpiSwiglu E{(bf16_t*)(ws + WS_H), IN(16) + (size_t)layer * NE * 2048};
            pg8::gemm_phase<pg8::EpiSwiglu, pg8::MoeSched<true, 8>, true>(lds, S, E, tid);
        }
#endif
        xcd_barrier(bar, wid0);
#if PHASE_ON(7)
    asm volatile("; PHASE_MARK 7");
        {
            PHASE_PTRS();
            pg8::MoeSched<false, 4> S{(const bf16_t*)(ws + WS_H), (const bf16_t*)(ws + WS_WDN) + (size_t)layer * NE * 1024 * 1024, (const int*)(ws + WS_TOK), tabs, G, bid};
            pg8::EpiDown E{(bf16_t*)(ws + WS_Y2), IN(18) + (size_t)layer * NE * 1024};
            pg8::gemm_phase<pg8::EpiDown, pg8::MoeSched<false, 4>, true>(lds, S, E, tid);
        }
#endif
        xcd_barrier(bar, wid0);
#if PHASE_ON(8)
    asm volatile("; PHASE_MARK 8");
        {
            PHASE_PTRS();
            const float* g2 = IN(19) + layer * 1024; const float* b2 = IN(20) + layer * 1024;
            const float* X1F = (const float*)(ws + WS_X1F); const bf16_t* Y2 = (const bf16_t*)(ws + WS_Y2); bf16_t* XB = (bf16_t*)(ws + WS_XB);
            const int* PE = (const int*)(ws + WS_PE); const int* PS = PE + T * 4; const float* PG = (const float*)(PS + T * 4);
            float* xout = (layer == DEPTH - 1) ? ap_->out : (float*)(ws + WS_XF);
            for (int row = bid * NWAVES + wid; row < T; row += G * NWAVES) {
                f32x4 v[4];
#pragma unroll
                for (int j = 0; j < 4; ++j) v[j] = *(const f32x4*)(X1F + (size_t)row * 1024 + lane * 4 + 256 * j) * DN_ALPHA;
#pragma unroll
                for (int k = 0; k < 4; ++k) {
                    const int ee = PE[row * 4 + k], slot = PS[row * 4 + k]; const float gg = PG[row * 4 + k];
                    const bf16_t* yr = Y2 + ((size_t)t_tstart[ee] * 256 + slot) * 1024 + lane * 4;
#pragma unroll
                    for (int j = 0; j < 4; ++j) { const u32x2 w = *(const u32x2*)(yr + 256 * j);
                        v[j][0] += gg * __uint_as_float(w.x << 16); v[j][1] += gg * __uint_as_float(w.x & 0xffff0000u); v[j][2] += gg * __uint_as_float(w.y << 16); v[j][3] += gg * __uint_as_float(w.y & 0xffff0000u); }
                }
                float s = 0.f;
#pragma unroll
                for (int j = 0; j < 4; ++j) s += (v[j][0] + v[j][1]) + (v[j][2] + v[j][3]);
                const float mean = wave_sum(s) * (1.0f / 1024.0f);
                float s2 = 0.f;
#pragma unroll
                for (int j = 0; j < 4; ++j) { v[j] = v[j] - mean; s2 += (v[j][0] * v[j][0] + v[j][1] * v[j][1]) + (v[j][2] * v[j][2] + v[j][3] * v[j][3]); }
                const float rstd = rsqrtf(wave_sum(s2) * (1.0f / 1024.0f) + LN_EPS);
#pragma unroll
                for (int j = 0; j < 4; ++j) {
                    const f32x4 gv = *(const f32x4*)(g2 + lane * 4 + 256 * j), bv = *(const f32x4*)(b2 + lane * 4 + 256 * j);
                    const f32x4 o = v[j] * rstd * gv + bv;
                    *(f32x4*)(xout + (size_t)row * 1024 + lane * 4 + 256 * j) = o;
                    u32x2 w; w.x = cvtpk(o[0], o[1]); w.y = cvtpk(o[2], o[3]);
                    *(u32x2*)(XB + (size_t)row * 1024 + lane * 4 + 256 * j) = w;
                }
            }
        }
#endif
        if (layer + 1 < DEPTH) xcd_barrier(bar, wid0);
}

__global__ void __launch_bounds__(NTHR, 2) mega_fwd(Args args) {
    extern __shared__ __attribute__((aligned(16))) unsigned char lds_raw[];
    LAS unsigned char* lds = (LAS unsigned char*)lds_raw;
    const int G = gridDim.x, bid = blockIdx.x;
    volatile LAS unsigned* misc = (volatile LAS unsigned*)(lds + LDS_MISC);
    const int wid0 = __builtin_amdgcn_readfirstlane((int)threadIdx.x >> 6);
    if (threadIdx.x < 16) misc[threadIdx.x] = 0u;
    __syncthreads();
    XcdBarrier bar = xcd_barrier_post((unsigned*)(args.ws + WS_CTL) + CW_BAR, misc, (int)threadIdx.x);
    volatile LAS int* qbc = (volatile LAS int*)(lds + LDS_MISC + 16);

#if PHASE_ON(0)
    asm volatile("; PHASE_MARK 0");
    {
        PHASE_PTRS();
        const float* x_in = IN(0); const float* w_in = IN(2); const float* w_out = IN(10); const float* router_w = IN(13); const float* w_gu = IN(15); const float* w_down = IN(17);
        bf16_t* WIN = (bf16_t*)(ws + WS_WIN); bf16_t* WOUT = (bf16_t*)(ws + WS_WOUT); bf16_t* RWT = (bf16_t*)(ws + WS_RWT); bf16_t* WGU = (bf16_t*)(ws + WS_WGU); bf16_t* WDN = (bf16_t*)(ws + WS_WDN); bf16_t* XB = (bf16_t*)(ws + WS_XB);
        const int gw = bid * NWAVES + wid, NGW = G * NWAVES;
        constexpr int I_IN = (PW / 64) * 16, I_OUT = 16 * 16, I_GU = 32 * 16, I_DN = 16 * 16, I_RW = 16;
        constexpr int N_IN = DEPTH * I_IN, N_OUT = DEPTH * I_OUT, N_GU = DEPTH * NE * I_GU, N_DN = DEPTH * NE * I_DN, N_RW = DEPTH * I_RW;
        constexpr int NITEMS = N_IN + N_OUT + N_GU + N_DN + N_RW;
        for (int it = gw; it < NITEMS; it += NGW) {
            int r = it;
            if (r < N_IN) { const int l = r / I_IN, q = r % I_IN, nb = q / 16, kb = q % 16; const int n = nb * 64 + lane; const int sc = win_src_col(n);
                cvt_item(w_in + (size_t)l * 1024 * NIN, NIN, sc, sc >= 0, WIN + ((size_t)l * PW + n) * 1024, kb * 64); continue; } r -= N_IN;
            if (r < N_OUT) { const int l = r / I_OUT, q = r % I_OUT, nb = q / 16, kb = q % 16; const int n = nb * 64 + lane;
                cvt_item(w_out + (size_t)l * 1024 * 1024, 1024, n, true, WOUT + ((size_t)l * 1024 + n) * 1024, kb * 64); continue; } r -= N_OUT;
            if (r < N_GU) { const int le = r / I_GU, q = r % I_GU, nb = q / 16, kb = q % 16; const int n = nb * 64 + lane;
                cvt_item(w_gu + (size_t)le * 1024 * 2048, 2048, n, true, WGU + ((size_t)le * 2048 + n) * 1024, kb * 64); continue; } r -= N_GU;
            if (r < N_DN) { const int le = r / I_DN, q = r % I_DN, nb = q / 16, kb = q % 16; const int n = nb * 64 + lane;
                cvt_item(w_down + (size_t)le * 1024 * 1024, 1024, n, true, WDN + ((size_t)le * 1024 + n) * 1024, kb * 64); continue; } r -= N_DN;
            { const int l = r / I_RW, kb = r % I_RW;
              if (lane < 32) { const float* src = router_w + (size_t)l * 1024 * 32; bf16_t* dh = RWT + ((size_t)(l * 2 + 0) * 32 + lane) * 1024 + kb * 64; bf16_t* dl = RWT + ((size_t)(l * 2 + 1) * 32 + lane) * 1024 + kb * 64;
                  for (int j = 0; j < 64; ++j) { const float v = src[(size_t)(kb * 64 + j) * 32 + lane]; const bf16_t hb_ = f2bf(v); dh[j] = hb_; dl[j] = f2bf(v - bf2f(hb_)); } } }
        }
        for (size_t i = (size_t)bid * NTHR + tid; i < (size_t)T * D / 4; i += (size_t)G * NTHR) { const f32x4 v = *(const f32x4*)(x_in + i * 4); u32x2 w; w.x = cvtpk(v[0], v[1]); w.y = cvtpk(v[2], v[3]); *(u32x2*)(XB + i * 4) = w; }
    }
#endif
    xcd_barrier(bar, wid0);

    run_layer<0>(lds, bar, qbc, G, bid, wid0);
    run_layer<1>(lds, bar, qbc, G, bid, wid0);
    run_layer<2>(lds, bar, qbc, G, bid, wid0);
    run_layer<3>(lds, bar, qbc, G, bid, wid0);
}

extern "C" void kernel_launch(void* const* d_in, const int* in_sizes, int n_in, void* d_out, int out_size, void* d_ws, size_t ws_size, hipStream_t stream) {
    static int grid = 0;
    if (grid == 0) {
        if (n_in != 21 || out_size != T * D || ws_size < WS_END) { fprintf(stderr, "kernel_launch: unexpected problem: n_in %d out %d ws %zu (need %zu)\n", n_in, out_size, ws_size, (size_t)WS_END); grid = -1; return; }
        int dev = 0, cus = 0, per_cu = 0;
        if (hipGetDevice(&dev) != hipSuccess || hipDeviceGetAttribute(&cus, hipDeviceAttributeMultiprocessorCount, dev) != hipSuccess) { fprintf(stderr, "kernel_launch: device query failed\n"); grid = -1; return; }
        if (hipFuncSetAttribute((const void*)mega_fwd, hipFuncAttributeMaxDynamicSharedMemorySize, LDS_BYTES) != hipSuccess) { fprintf(stderr, "kernel_launch: hipFuncSetAttribute failed\n"); grid = -1; return; }
        if (hipOccupancyMaxActiveBlocksPerMultiprocessor(&per_cu, (const void*)mega_fwd, NTHR, LDS_BYTES) != hipSuccess || per_cu < 1)
            fprintf(stderr, "kernel_launch: note: occupancy query reports %d workgroups per CU\n", per_cu);
        (void)hipGetLastError();
        grid = cus > 256 ? 256 : cus;
    }
    if (grid < 0) return;
    if (hipMemsetAsync((char*)d_ws + WS_CTL, 0, CTL_ZERO_BYTES, stream) != hipSuccess) { fprintf(stderr, "kernel_launch: memset failed\n"); return; }
    Args a{};
    for (int i = 0; i < 21; ++i) a.in[i] = (const float*)d_in[i];
    a.out = (float*)d_out; a.ws = (unsigned char*)d_ws;
    hipLaunchKernelGGL(mega_fwd, dim3(grid), dim3(NTHR), LDS_BYTES, stream, a);
    const hipError_t le = hipPeekAtLastError();
    if (le != hipSuccess) fprintf(stderr, "kernel_launch: launch failed: %s\n", hipGetErrorName(le));
}
```

```cpp
#include <hip/hip_runtime.h>
#include <hip/hip_bf16.h>
#include <cstdio>
#include <cstdint>
#include <cmath>

#define LAS __attribute__((address_space(3)))
typedef unsigned short bf16_t;
typedef short bf16x8 __attribute__((ext_vector_type(8)));
typedef short s16x4 __attribute__((ext_vector_type(4)));
typedef float f32x4 __attribute__((ext_vector_type(4)));
typedef float f32x2 __attribute__((ext_vector_type(2)));
typedef float f32x16 __attribute__((ext_vector_type(16)));
typedef unsigned u32x4 __attribute__((ext_vector_type(4)));
typedef unsigned u32x2 __attribute__((ext_vector_type(2)));
typedef __bf16 bf16x2_t __attribute__((ext_vector_type(2)));

constexpr int NB = 2, SEQ = 8192, T = NB * SEQ, D = 1024, DEPTH = 4;
constexpr int NIN = 3144, PW = 3328;
constexpr int C_FQ = 0, C_FK = 256, C_FV = 512, C_DQ = 768, C_DK = 1024, C_DV = 1280, C_SQ = 1536, C_SK = 1792, C_SV = 2048, C_IQ = 2304, C_IK = 2560, C_CU = 2624, C_FF = 3136, C_IW = 3140;
constexpr int NE = 32, TOPK = 4, ECAP = T;
constexpr int MAXTILES = 288;
constexpr float LN_EPS = 1e-5f;
constexpr float DN_ALPHA = 1.681792830507429f;
constexpr float LOG2E = 1.4426950408889634f;
constexpr int NWAVES = 8, NTHR = 512;

constexpr size_t MiB = 1u << 20;
constexpr size_t WS_CTL = 0, CTL_ZERO_BYTES = 1 * MiB;
constexpr size_t WS_WIN = 1 * MiB;
constexpr size_t WS_WOUT = 27 * MiB;
constexpr size_t WS_RWT = 35 * MiB;
constexpr size_t WS_WGU = 36 * MiB;
constexpr size_t WS_WDN = 548 * MiB;
constexpr size_t WS_XF = 804 * MiB;
constexpr size_t WS_XB = 868 * MiB;
constexpr size_t WS_PROJ = 900 * MiB;
constexpr size_t WS_Y = 1004 * MiB;
constexpr size_t WS_PRE = 1036 * MiB;
constexpr size_t WS_X1F = 1100 * MiB;
constexpr size_t WS_X1B = 1164 * MiB;
constexpr size_t WS_SEL = 1196 * MiB;
constexpr size_t WS_SCR = 1212 * MiB;
constexpr size_t WS_TOK = 1468 * MiB;
constexpr size_t WS_PE = 1470 * MiB;
constexpr size_t WS_H = 1472 * MiB;
constexpr size_t WS_Y2 = 1616 * MiB;
constexpr size_t WS_END = 1760 * MiB;
constexpr int CW_BAR = 0;
constexpr int CW_Q = 4096;
constexpr int CW_ECNT = 8192;

constexpr int RING_BYTES = 131072;
constexpr int LDS_TAB = RING_BYTES;
constexpr int LDS_MISC = RING_BYTES + 2048;
constexpr int LDS_BYTES = 163840;

#ifndef PROBE_MASK
#define PROBE_MASK 0
#endif
#define PROBE_T0(n) unsigned long long pt0_ = 0; if ((PROBE_MASK >> (n)) & 1) pt0_ = __builtin_amdgcn_s_memrealtime()
#define PROBE_SPIN(n) do { if ((PROBE_MASK >> (n)) & 1) { const unsigned long long t1_ = __builtin_amdgcn_s_memrealtime(); const unsigned long long d_ = t1_ - pt0_; while (__builtin_amdgcn_s_memrealtime() - t1_ < d_) __builtin_amdgcn_s_sleep(8); } } while (0)
__device__ __forceinline__ float bf2f(bf16_t v) { return __uint_as_float((unsigned)v << 16); }
__device__ __forceinline__ unsigned cvtpk(float lo, float hi) { f32x2 v = {lo, hi}; bf16x2_t b = __builtin_convertvector(v, bf16x2_t); return __builtin_bit_cast(unsigned, b); }
__device__ __forceinline__ bf16_t f2bf(float f) { return (bf16_t)(cvtpk(f, 0.f) & 0xffffu); }
__device__ __forceinline__ float wave_sum(float v) {
#pragma unroll
    for (int o = 1; o < 64; o <<= 1) v += __shfl_xor(v, o);
    return v;
}
__device__ __forceinline__ float sigmoidf_(float x) { return 1.0f / (1.0f + __expf(-x)); }
__device__ __forceinline__ int lane_id_() { int l; asm volatile("v_mbcnt_lo_u32_b32 %0, -1, 0\n\tv_mbcnt_hi_u32_b32 %0, -1, %0" : "=&v"(l)); return l; }
#define LDS_WAIT() asm volatile("s_waitcnt lgkmcnt(0)" ::: "memory")
#define VM_WAIT() asm volatile("s_waitcnt vmcnt(0)" ::: "memory")

#define XB_TMO      128
#define XB_XCNT(j)  (256  + 64 * (j))
#define XB_XSUB(j)  (1280 + 64 * (j))
#define XB_XGEN(j)  (2304 + 64 * (j))
#define XB_TOP      3328
#define XB_TOPGEN   3392
#define XCD_BAR_WORDS 3456
#define XB_SPIN_CAP (1u << 20)

__device__ __forceinline__ unsigned xb_ld(unsigned* p)              { return __hip_atomic_load(p, __ATOMIC_RELAXED, __HIP_MEMORY_SCOPE_AGENT); }
__device__ __forceinline__ unsigned xb_add(unsigned* p, unsigned v) { return __hip_atomic_fetch_add(p, v, __ATOMIC_RELAXED, __HIP_MEMORY_SCOPE_AGENT); }
__device__ __forceinline__ unsigned xb_xcc_id() { return (unsigned)__builtin_amdgcn_s_getreg((3 << 11) | 20) & 0xFu; }
#define XB_SPIN(cond, bar) do { unsigned _sp = 0; while (cond) { __builtin_amdgcn_s_sleep(1); \
    if ((++_sp & 255u) == 0u) { if (xb_ld(&(bar)[XB_TMO])) break; if (_sp > XB_SPIN_CAP) { atomicAdd(&(bar)[XB_TMO], 1u); break; } } } } while (0)

struct XcdBarrier { unsigned* bar; unsigned x; volatile LAS unsigned* st; };

__device__ __forceinline__ XcdBarrier xcd_barrier_post(unsigned* bar, volatile LAS unsigned* st, int tid) {
    XcdBarrier b; b.bar = bar; b.x = xb_xcc_id(); b.st = st;
    if (tid == 0) (void)xb_add(&bar[XB_XCNT(b.x)], 1u);
    return b;
}
__device__ __forceinline__ void xcd_barrier_complete(unsigned* bar, unsigned x, unsigned& nloc, unsigned& nx) {
    const unsigned G = gridDim.x * gridDim.y * gridDim.z;
    unsigned sum, cnt, mine, sp = 0u;
    for (;;) {
        sum = 0u; cnt = 0u; mine = 0u;
#pragma unroll
        for (unsigned j = 0; j < 16; ++j) { const unsigned c = xb_ld(&bar[XB_XCNT(j)]); sum += c; cnt += (c > 0u) ? 1u : 0u; mine = (j == x) ? c : mine; }
        if (sum == G) break;
        __builtin_amdgcn_s_sleep(1);
        if ((++sp & 255u) == 0u) { if (xb_ld(&bar[XB_TMO])) break; if (sp > XB_SPIN_CAP) { atomicAdd(&bar[XB_TMO], 1u); break; } }
    }
    nloc = mine > 0u ? mine : 1u; nx = cnt > 0u ? cnt : 1u;
}
__device__ __forceinline__ void xcd_barrier(const XcdBarrier& b, int wid0) {
    asm volatile("s_waitcnt vmcnt(0)" ::: "memory");
    __syncthreads();
    if (wid0 == 0 && lane_id_() == 0) {
        unsigned* bar = b.bar;
        __builtin_amdgcn_s_waitcnt(0);
        unsigned nloc = b.st[0], nx = b.st[1];
        if (nloc == 0u) { xcd_barrier_complete(bar, b.x, nloc, nx); b.st[0] = nloc; b.st[1] = nx; }
        const unsigned old = xb_add(&bar[XB_XSUB(b.x)], 1u);
        const unsigned gen = old / nloc;
        if (old + 1u == (gen + 1u) * nloc) {
            __builtin_amdgcn_fence(__ATOMIC_RELEASE, "agent");
            asm volatile("s_waitcnt vmcnt(0)" ::: "memory");
            const unsigned og = xb_add(&bar[XB_TOP], 1u);
            const unsigned tg = og / nx;
            if (og + 1u == (tg + 1u) * nx) xb_add(&bar[XB_TOPGEN], 1u);
            else XB_SPIN(xb_ld(&bar[XB_TOPGEN]) == tg, bar);
            __builtin_amdgcn_fence(__ATOMIC_ACQUIRE, "agent");
            xb_add(&bar[XB_XGEN(b.x)], 1u);
            asm volatile("s_waitcnt vmcnt(0)" ::: "memory");
        } else {
            XB_SPIN(xb_ld(&bar[XB_XGEN(b.x)]) == gen, bar);
            __builtin_amdgcn_fence(__ATOMIC_ACQUIRE, "agent");
            asm volatile("s_waitcnt vmcnt(0)" ::: "memory");
        }
    }
    __syncthreads();
}

namespace pg8 {
constexpr int BM = 256, BK = 64, HALF = 128, HTB = HALF * BK * 2, STAGE_BYTES = 8 * HTB, KD = 1024, VOFF_LDS = STAGE_BYTES + 4096, BIAS_LDS = 153600;
__host__ __device__ __forceinline__ int lds_byte(int r, int c) { const int st = (r >> 4) * 2 + (c >> 5), rr = r & 15, cc = c & 31, ob = rr * 64 + cc * 2; return st * 1024 + (ob ^ (((ob >> 9) & 1) << 5)); }
__host__ __device__ __forceinline__ void stage_rc(int b, int& R, int& C) { const int st = b / 1024, sb = b % 1024, swz = sb ^ (((sb >> 9) & 1) << 5); R = (st >> 1) * 16 + swz / 64; C = (st & 1) * 32 + (swz % 64) / 2; }
__host__ __device__ __forceinline__ int perm32(int rho) { const int n = rho >> 4, i = rho & 15; return 8 * (i >> 2) + 4 * n + (i & 3); }

struct Unit { int pm, pn, e, ord, kind; };

template <class Epi, class Sched, bool ALIGN_EPI>
__device__ __forceinline__ void gemm_phase(LAS unsigned char* lds, const Sched& S, const Epi& E, const int tid) {
    const int wid = __builtin_amdgcn_readfirstlane(tid >> 6), lane = tid & 63, wr = wid >> 2, wc = wid & 3, fr = lane & 15, fq = lane >> 4;
    constexpr int K = KD, nt = K / BK;
    int Rr[2], Cc[2]; unsigned voffB[2];
#pragma unroll
    for (int i = 0; i < 2; ++i) { int R, C; stage_rc(tid * 16 + i * 8192, R, C); const int Rb = Epi::PERM ? ((R & ~31) + perm32(R & 31)) : R; Rr[i] = R; Cc[i] = C; voffB[i] = (unsigned)(Rb * K + C) * 2u; }
    constexpr size_t kstep = (size_t)(BK * 2);
    constexpr size_t hstep = (size_t)HALF * K * 2;
    const unsigned ldsw = (unsigned)wid * 1024u;
    const int aoff = lds_byte(wr * 64 + fr, fq * 8), boff = lds_byte(wc * 32 + fr, fq * 8);
#define PG8_SA(b, h) (((b) * 2 + (h)) * HTB)
#define PG8_SB(b, h) ((4 + (b) * 2 + (h)) * HTB)
#define PG8_STAGE(bufoff, gbase, voff) do { _Pragma("unroll") for (int _i = 0; _i < 2; ++_i) \
        __builtin_amdgcn_global_load_lds((const unsigned*)((const char*)(gbase) + (voff)[_i]), (LAS unsigned*)(lds + (bufoff) + ldsw + _i * 8192), 16, 0, 0); } while (0)
#define PG8_LDA(dst, b, h) do { _Pragma("unroll") for (int m = 0; m < 4; ++m) _Pragma("unroll") for (int k = 0; k < 2; ++k) dst[m][k] = *(const LAS bf16x8*)(lds + PG8_SA(b, h) + aoff + m * 2048 + k * 1024); } while (0)
#define PG8_LDB(dst, b, h) do { _Pragma("unroll") for (int n = 0; n < 2; ++n) _Pragma("unroll") for (int k = 0; k < 2; ++k) dst[n][k] = *(const LAS bf16x8*)(lds + PG8_SB(b, h) + boff + n * 2048 + k * 1024); } while (0)
#define PG8_MMA(ai, bj, At, Bt) do { __builtin_amdgcn_s_setprio(1); _Pragma("unroll") for (int m = 0; m < 4; ++m) _Pragma("unroll") for (int n = 0; n < 2; ++n) _Pragma("unroll") for (int k = 0; k < 2; ++k) \
        acc[ai][bj][m][n] = __builtin_amdgcn_mfma_f32_16x16x32_bf16(Bt[n][k], At[m][k], acc[ai][bj][m][n], 0, 0, 0); __builtin_amdgcn_s_setprio(0); } while (0)
#define PG8_WAIT_V(n) asm volatile("s_waitcnt vmcnt(" #n ")" ::: "memory")
#define PG8_WAIT_L(n) asm volatile("s_waitcnt lgkmcnt(" #n ")" ::: "memory")
#define PG8_BAR __builtin_amdgcn_s_barrier()
#define PG8_SCHED __builtin_amdgcn_sched_barrier(0)
    Unit cur, nxt; int ui = 0;
    if (!S.next(0, cur)) return;
    f32x4 acc[2][2][4][2];
#pragma unroll
    for (int a = 0; a < 2; ++a)
#pragma unroll
        for (int b = 0; b < 2; ++b)
#pragma unroll
            for (int m = 0; m < 4; ++m)
#pragma unroll
                for (int n = 0; n < 2; ++n) acc[a][b][m][n] = (f32x4){0.f, 0.f, 0.f, 0.f};
    bf16x8 At[4][2], B0[2][2], B1[2][2];
    constexpr bool GA = Sched::GATHER;
    unsigned vAc[2][2], vAn[2][2];
    if constexpr (GA) S.a_voff(cur, tid, vAc);
    else {
#pragma unroll
        for (int i = 0; i < 2; ++i) { vAc[0][i] = (unsigned)(Rr[i] * K + Cc[i]) * 2u; vAc[1][i] = vAc[0][i]; vAn[0][i] = vAc[0][i]; vAn[1][i] = vAc[0][i]; }
    }
    constexpr size_t ah = GA ? (size_t)0 : hstep;
    const char* cA = S.a_base(cur); const char* cB = S.b_base(cur);
    PG8_STAGE(PG8_SB(0, 0), cB, voffB); PG8_STAGE(PG8_SB(0, 1), cB + hstep, voffB); PG8_STAGE(PG8_SA(0, 0), cA, vAc[0]); PG8_STAGE(PG8_SA(0, 1), cA + ah, vAc[1]);
    if (wr == 1) PG8_BAR;
    PG8_WAIT_V(2); PG8_BAR;
    PG8_STAGE(PG8_SB(1, 0), cB + kstep, voffB); PG8_STAGE(PG8_SA(1, 0), cA + kstep, vAc[0]); PG8_STAGE(PG8_SB(1, 1), cB + hstep + kstep, voffB);
    PG8_WAIT_V(6); PG8_BAR;
    for (;;) {
        const bool has_next = S.next(ui + 1, nxt);
        if constexpr (Epi::LDS_BIAS) { if (wid == 0) __builtin_amdgcn_global_load_lds((const unsigned*)(E.bias_src(cur) + lane * 4), (LAS unsigned*)(lds + BIAS_LDS + (ui & 1) * 1024), 16, 0, 0); }
        const char* nA = has_next ? S.a_base(nxt) : cA; const char* nB = has_next ? S.b_base(nxt) : cB;
        if constexpr (GA) {
            if (has_next) S.a_voff(nxt, tid, vAn);
            else { vAn[0][0] = vAc[0][0]; vAn[0][1] = vAc[0][1]; vAn[1][0] = vAc[1][0]; vAn[1][1] = vAc[1][1]; }
            *(LAS u32x4*)(lds + VOFF_LDS + tid * 16) = (u32x4){vAn[0][0], vAn[0][1], vAn[1][0], vAn[1][1]};
        }
        for (int t = 0; t < nt; t += 2) {
            const bool last = (t == nt - 2);
            const char* a1 = cA + (size_t)(t + 1) * kstep;
            const char* a2 = last ? nA : cA + (size_t)(t + 2) * kstep; const char* b2 = last ? nB : cB + (size_t)(t + 2) * kstep;
            const char* a3 = a2 + kstep; const char* b3 = b2 + kstep;
            PG8_LDB(B0, 0, 0); PG8_LDB(B1, 0, 1); PG8_SCHED; PG8_LDA(At, 0, 0); PG8_STAGE(PG8_SA(1, 1), a1 + ah, vAc[1]);
            if constexpr (GA) { if (last) { const u32x4 nv = *(const LAS u32x4*)(lds + VOFF_LDS + tid * 16); vAc[0][0] = nv[0]; vAc[0][1] = nv[1]; vAc[1][0] = nv[2]; vAc[1][1] = nv[3]; } }
            PG8_WAIT_V(8); PG8_WAIT_L(0); PG8_BAR; PG8_MMA(0, 0, At, B0); PG8_MMA(0, 1, At, B1); PG8_BAR; PG8_SCHED;
            PG8_LDA(At, 0, 1); PG8_STAGE(PG8_SB(0, 0), b2, voffB); PG8_STAGE(PG8_SB(0, 1), b2 + hstep, voffB); PG8_STAGE(PG8_SA(0, 0), a2, vAc[0]);
            PG8_WAIT_V(8); PG8_WAIT_L(0); PG8_BAR; PG8_MMA(1, 0, At, B0); PG8_MMA(1, 1, At, B1); PG8_BAR; PG8_SCHED;
            PG8_LDB(B0, 1, 0); PG8_LDB(B1, 1, 1); PG8_SCHED; PG8_LDA(At, 1, 0); PG8_STAGE(PG8_SA(0, 1), a2 + ah, vAc[1]);
            PG8_WAIT_V(8); PG8_WAIT_L(0); PG8_BAR; PG8_MMA(0, 0, At, B0); PG8_MMA(0, 1, At, B1); PG8_BAR; PG8_SCHED;
            PG8_LDA(At, 1, 1); PG8_STAGE(PG8_SB(1, 0), b3, voffB); PG8_STAGE(PG8_SB(1, 1), b3 + hstep, voffB); PG8_STAGE(PG8_SA(1, 0), a3, vAc[0]);
            PG8_WAIT_V(8); PG8_WAIT_L(0); PG8_BAR; PG8_MMA(1, 0, At, B0); PG8_MMA(1, 1, At, B1); PG8_BAR; PG8_SCHED;
        }
        if constexpr (ALIGN_EPI) { if (wr == 0) PG8_BAR; }
        { int te = tid; asm volatile("" : "+v"(te)); const int lw = __builtin_amdgcn_readfirstlane(te >> 6); E(acc, cur, lw >> 2, lw & 3, te & 15, (te & 63) >> 4, (const LAS float*)(lds + BIAS_LDS + (ui & 1) * 1024)); }
        if (!has_next) break;
#pragma unroll
        for (int a = 0; a < 2; ++a)
#pragma unroll
            for (int b = 0; b < 2; ++b)
#pragma unroll
                for (int m = 0; m < 4; ++m)
#pragma unroll
                    for (int n = 0; n < 2; ++n) acc[a][b][m][n] = (f32x4){0.f, 0.f, 0.f, 0.f};
        cur = nxt; cA = nA; cB = nB; ++ui;
        if constexpr (ALIGN_EPI) { if (wr == 1) PG8_BAR; }
    }
    PG8_WAIT_V(0);
    if constexpr (!ALIGN_EPI) { if (wr == 0) PG8_BAR; }
    PG8_BAR;
#undef PG8_SA
#undef PG8_SB
#undef PG8_STAGE
#undef PG8_LDA
#undef PG8_LDB
#undef PG8_MMA
#undef PG8_WAIT_V
#undef PG8_WAIT_L
#undef PG8_BAR
#undef PG8_SCHED
}

struct DenseSched {
    const bf16_t* A; const bf16_t* Bt; int nM, nN, nwg, G, c;
    __device__ __forceinline__ void init(const bf16_t* A_, const bf16_t* Bt_, int M, int N, int G_, int c_) { A = A_; Bt = Bt_; nM = M / BM; nN = N / BM; nwg = nM * nN; G = G_; c = c_; }
    __device__ __forceinline__ bool next(int i, Unit& u) const {
        const long L = (long)i * G + c; if (L >= nwg) return false;
        int wgid = (int)L; { const int q = nwg / 8, r = nwg % 8, xcd = wgid % 8, off = wgid / 8; wgid = (xcd < r ? xcd * (q + 1) : r * (q + 1) + (xcd - r) * q) + off; }
        const int nig = 8 * nN, gid = wgid / nig, fm = gid * 8, gsz = (nM - fm) < 8 ? (nM - fm) : 8;
        u.pm = fm + ((wgid % nig) % gsz); u.pn = (wgid % nig) / gsz; u.e = 0; u.ord = i; u.kind = 0; return true;
    }
    static constexpr bool GATHER = false;
    __device__ __forceinline__ const char* a_base(const Unit& u) const { return (const char*)A + (size_t)u.pm * BM * KD * 2; }
    __device__ __forceinline__ const char* b_base(const Unit& u) const { return (const char*)Bt + (size_t)u.pn * BM * KD * 2; }
};
struct MoeTabs { const LAS int* texp; const LAS int* tstart; const LAS int* cnt; int ntiles; };
struct MoeShift { int on, nOwn, nSh, ntS;
    __device__ __forceinline__ void init(int ntiles, int G) { on = (G == 256 && ntiles > 256 && ntiles < 288) ? 1 : 0; nOwn = on ? 8 * (288 - ntiles) : 0; nSh = 256 - nOwn; ntS = on ? nSh * 9 / 8 : ntiles; } };
struct MoeSchedA {
    const bf16_t* X1B; const bf16_t* Hm; const bf16_t* Wgu; const bf16_t* Wdn; const LAS int* tokl; MoeTabs tb; MoeShift sh; int G, c;
    __device__ __forceinline__ bool next(int i, Unit& u) const {
        if (!sh.on) { const long L = (long)i * G + c; if (L >= (long)tb.ntiles * 8) return false; u.pm = (int)(L >> 3); u.pn = (int)(L & 7); u.kind = 0; }
        else { if (i >= 9) return false;
            if (c < sh.nSh) { const int L = (c & 7) * sh.ntS + i * (sh.nSh >> 3) + (c >> 3); u.pm = L >> 3; u.pn = L & 7; u.kind = 0; }
            else { const int j = c - sh.nSh; u.pm = sh.ntS + (j & 7) * (sh.nOwn >> 3) + (j >> 3); u.pn = i & 7; u.kind = i >> 3; } }
        u.e = __builtin_amdgcn_readfirstlane(tb.texp[u.pm]); u.ord = i; return true;
    }
    static constexpr bool GATHER = true;
    __device__ __forceinline__ const char* a_base(const Unit& u) const { return u.kind ? (const char*)Hm : (const char*)X1B; }
    __device__ __forceinline__ const char* b_base(const Unit& u) const { return u.kind ? (const char*)Wdn + ((size_t)u.e * 4 + u.pn) * BM * KD * 2 : (const char*)Wgu + ((size_t)u.e * 8 + u.pn) * BM * KD * 2; }
    __device__ __forceinline__ void a_voff(const Unit& u, int tid, unsigned (&v)[2][2]) const {
#pragma unroll
        for (int i = 0; i < 2; ++i) { int R, C; stage_rc(tid * 16 + i * 8192, R, C);
#pragma unroll
            for (int h = 0; h < 2; ++h) { int tk; if (u.kind) tk = u.pm * BM + h * HALF + R; else tk = tokl[u.ord * BM + h * HALF + R]; v[h][i] = (unsigned)(tk * KD + C) * 2u; } }
    }
};
struct MoeSchedB {
    const bf16_t* A; const bf16_t* Bt; MoeTabs tb; MoeShift sh; int G, c;
    __device__ __forceinline__ bool next(int i, Unit& u) const {
        const int ntot = tb.ntiles * 4 - sh.nOwn; int L;
        if (G == 256) {
            const int q = ntot >> 3, rem = ntot & 7, x = c & 7, j = c >> 3, size = q + (x < rem ? 1 : 0), start = x * q + (x < rem ? x : rem), m = i * 32 + j;
            if (m >= size) return false; L = start + m; }
        else { L = i * G + c; if (L >= ntot) return false; }
        if (L < sh.ntS * 4) { u.pm = L >> 2; u.pn = L & 3; } else { const int L2 = L - sh.ntS * 4, q = L2 / 3; u.pm = sh.ntS + q; u.pn = 1 + (L2 - 3 * q); }
        u.e = __builtin_amdgcn_readfirstlane(tb.texp[u.pm]); u.ord = i; u.kind = 1; return true;
    }
    static constexpr bool GATHER = false;
    __device__ __forceinline__ const char* a_base(const Unit& u) const { return (const char*)A + (size_t)u.pm * BM * KD * 2; }
    __device__ __forceinline__ const char* b_base(const Unit& u) const { return (const char*)Bt + ((size_t)u.e * 4 + u.pn) * BM * KD * 2; }
};

struct EpiProj {
    static constexpr bool PERM = true, LDS_BIAS = false;
    bf16_t* O;
    __device__ __forceinline__ void operator()(const f32x4 (&acc)[2][2][4][2], const Unit& u, int wr, int wc, int fr, int fq, const LAS float* bl) const {
        const int row0 = u.pm * BM + wr * 64 + fr, col0 = u.pn * BM + wc * 32 + 8 * fq;
#pragma unroll
        for (int ai = 0; ai < 2; ++ai)
#pragma unroll
            for (int m = 0; m < 4; ++m) { bf16_t* rowp = O + (size_t)(row0 + ai * HALF + m * 16) * PW + col0;
#pragma unroll
                for (int bj = 0; bj < 2; ++bj) { const f32x4 v0 = acc[ai][bj][m][0], v1 = acc[ai][bj][m][1];
                    u32x4 w; w.x = cvtpk(v0[0], v0[1]); w.y = cvtpk(v0[2], v0[3]); w.z = cvtpk(v1[0], v1[1]); w.w = cvtpk(v1[2], v1[3]);
                    *(u32x4*)(rowp + bj * HALF) = w; } }
    }
};
struct EpiPre {
    static constexpr bool PERM = false, LDS_BIAS = false;
    const bf16_t* X; float* O;
    __device__ __forceinline__ void operator()(const f32x4 (&acc)[2][2][4][2], const Unit& u, int wr, int wc, int fr, int fq, const LAS float* bl) const {
        const int row0 = u.pm * BM + wr * 64 + fr, col0 = u.pn * BM + wc * 32 + 4 * fq;
#pragma unroll
        for (int ai = 0; ai < 2; ++ai)
#pragma unroll
            for (int m = 0; m < 4; ++m) { const size_t off = (size_t)(row0 + ai * HALF + m * 16) * D + col0;
#pragma unroll
                for (int bj = 0; bj < 2; ++bj)
#pragma unroll
                    for (int n = 0; n < 2; ++n) { const u32x2 xw = *(const u32x2*)(X + off + bj * HALF + n * 16); const f32x4 xv = {__builtin_bit_cast(float, xw.x << 16), __builtin_bit_cast(float, xw.x & 0xffff0000u), __builtin_bit_cast(float, xw.y << 16), __builtin_bit_cast(float, xw.y & 0xffff0000u)};
                        *(f32x4*)(O + off + bj * HALF + n * 16) = xv * DN_ALPHA + acc[ai][bj][m][n]; } }
    }
};
struct EpiSwiglu {
    static constexpr bool PERM = true, LDS_BIAS = true;
    bf16_t* H; const float* bgu;
    __device__ __forceinline__ const float* bias_src(const Unit& u) const { return bgu + (size_t)u.e * 2048 + u.pn * BM; }
    __device__ __forceinline__ void operator()(const f32x4 (&acc)[2][2][4][2], const Unit& u, int wr, int wc, int fr, int fq, const LAS float* bl) const {
        const int row0 = u.pm * BM + wr * 64 + fr, col0 = u.pn * BM + wc * 32 + 8 * fq;
        const LAS float* bp = bl + wc * 32 + 8 * fq;
        f32x4 bv[2][2];
#pragma unroll
        for (int bj = 0; bj < 2; ++bj)
#pragma unroll
            for (int n = 0; n < 2; ++n) bv[bj][n] = *(const LAS f32x4*)(bp + bj * HALF + 4 * n);
#pragma unroll
        for (int ai = 0; ai < 2; ++ai)
#pragma unroll
            for (int m = 0; m < 4; ++m) { bf16_t* rowp = H + (size_t)(row0 + ai * HALF + m * 16) * 1024 + (col0 >> 1);
#pragma unroll
                for (int bj = 0; bj < 2; ++bj) { const f32x4 v0 = acc[ai][bj][m][0] + bv[bj][0], v1 = acc[ai][bj][m][1] + bv[bj][1];
                    float hv[4];
#pragma unroll
                    for (int j = 0; j < 4; ++j) { const float g_ = j < 2 ? v0[2 * j] : v1[2 * j - 4], u_ = j < 2 ? v0[2 * j + 1] : v1[2 * j - 3];
                        const float gate = fminf(g_, 7.0f), up = fminf(fmaxf(u_, -7.0f), 7.0f);
                        hv[j] = (up + 1.0f) * gate * __builtin_amdgcn_rcpf(1.0f + __builtin_amdgcn_exp2f(-1.702f * LOG2E * gate)); }
                    u32x2 w; w.x = cvtpk(hv[0], hv[1]); w.y = cvtpk(hv[2], hv[3]);
                    *(u32x2*)(rowp + bj * (HALF / 2)) = w; } }
    }
};
struct EpiDown {
    static constexpr bool PERM = true, LDS_BIAS = true;
    bf16_t* O; const float* bd;
    __device__ __forceinline__ const float* bias_src(const Unit& u) const { return bd + (size_t)u.e * 1024 + u.pn * BM; }
    __device__ __forceinline__ void operator()(const f32x4 (&acc)[2][2][4][2], const Unit& u, int wr, int wc, int fr, int fq, const LAS float* bl) const {
        const int row0 = u.pm * BM + wr * 64 + fr, col0 = u.pn * BM + wc * 32 + 8 * fq;
        const LAS float* bp = bl + wc * 32 + 8 * fq;
        f32x4 bv[2][2];
#pragma unroll
        for (int bj = 0; bj < 2; ++bj)
#pragma unroll
            for (int n = 0; n < 2; ++n) bv[bj][n] = *(const LAS f32x4*)(bp + bj * HALF + 4 * n);
#pragma unroll
        for (int ai = 0; ai < 2; ++ai)
#pragma unroll
            for (int m = 0; m < 4; ++m) { bf16_t* rowp = O + (size_t)(row0 + ai * HALF + m * 16) * 1024 + col0;
#pragma unroll
                for (int bj = 0; bj < 2; ++bj) { const f32x4 v0 = acc[ai][bj][m][0] + bv[bj][0], v1 = acc[ai][bj][m][1] + bv[bj][1];
                    u32x4 w; w.x = cvtpk(v0[0], v0[1]); w.y = cvtpk(v0[2], v0[3]); w.z = cvtpk(v1[0], v1[1]); w.w = cvtpk(v1[2], v1[3]);
                    *(u32x4*)(rowp + bj * HALF) = w; } }
    }
};
struct EpiMoe {
    static constexpr bool PERM = true, LDS_BIAS = true;
    EpiSwiglu es; EpiDown ed;
    __device__ __forceinline__ const float* bias_src(const Unit& u) const { return u.kind ? ed.bias_src(u) : es.bias_src(u); }
    __device__ __forceinline__ void operator()(const f32x4 (&acc)[2][2][4][2], const Unit& u, int wr, int wc, int fr, int fq, const LAS float* bl) const {
        if (u.kind == 0) es(acc, u, wr, wc, fr, fq, bl); else ed(acc, u, wr, wc, fr, fq, bl);
    }
};
}

__device__ __forceinline__ void glds16(const void* gsrc, unsigned lds_dst) { unsigned keep;
    asm volatile("s_mov_b32 %0, m0\n\ts_mov_b32 m0, %2\n\ts_nop 0\n\tglobal_load_lds_dwordx4 %1, off\n\ts_mov_b32 m0, %0" : "=&s"(keep) : "v"(gsrc), "s"(lds_dst) : "memory"); }
namespace att {
constexpr int NSLOT = 6, L_K = 0, L_V = 49152, L_CL = 98304, L_Q = 98304, L_TB = 131072, L_WT = 131584;
typedef short v4i16_t __attribute__((ext_vector_type(4)));
__device__ __forceinline__ s16x4 vtr(const LAS unsigned char* p) { return __builtin_bit_cast(s16x4, __builtin_amdgcn_ds_read_tr16_b64_v4i16((LAS v4i16_t*)p)); }
__device__ __forceinline__ int t5_bucket(int d) {
    if (d < 16) return d;
    int b = 16;
    b += (d >= 19); b += (d >= 21); b += (d >= 24); b += (d >= 27); b += (d >= 31); b += (d >= 35); b += (d >= 40); b += (d >= 46);
    b += (d >= 52); b += (d >= 59); b += (d >= 67); b += (d >= 77); b += (d >= 87); b += (d >= 99); b += (d >= 113);
    return b;
}
__device__ __forceinline__ int crow(int r, int hi) { return (r & 3) + 8 * (r >> 2) + 4 * hi; }

constexpr float ATT_THR = 8.0f;
__device__ __forceinline__ void softmax2(f32x16& s0, f32x16& s1, float& m, float& l, f32x16 (&o)[2], u32x4 (&pk)[4]) {
    float a = fmaxf(fmaxf(s0[0], s0[1]), s1[0]), c = fmaxf(fmaxf(s0[2], s0[3]), s1[1]);
    a = fmaxf(fmaxf(a, s1[2]), s1[3]);
#pragma unroll
    for (int r = 4; r < 16; r += 4) { a = fmaxf(fmaxf(a, s0[r]), s0[r + 1]); c = fmaxf(fmaxf(c, s0[r + 2]), s0[r + 3]); a = fmaxf(fmaxf(a, s1[r]), s1[r + 1]); c = fmaxf(fmaxf(c, s1[r + 2]), s1[r + 3]); }
    float rm = fmaxf(a, c);
    rm = fmaxf(rm, __shfl_xor(rm, 32));
    if (__any(rm > ATT_THR)) {
        const float d = fmaxf(rm, 0.f);
        m += d;
        const float f = __builtin_amdgcn_exp2f(-d);
        l *= f;
#pragma unroll
        for (int r = 0; r < 16; ++r) { s0[r] -= d; s1[r] -= d; o[0][r] *= f; o[1][r] *= f; }
    }
    float rs = 0.f;
#pragma unroll
    for (int r = 0; r < 16; ++r) { s0[r] = __builtin_amdgcn_exp2f(s0[r]); rs += s0[r]; }
#pragma unroll
    for (int r = 0; r < 16; ++r) { s1[r] = __builtin_amdgcn_exp2f(s1[r]); rs += s1[r]; }
    l += rs;
#pragma unroll
    for (int i = 0; i < 4; ++i) { pk[0][i] = cvtpk(s0[2 * i], s0[2 * i + 1]); pk[1][i] = cvtpk(s0[8 + 2 * i], s0[8 + 2 * i + 1]); pk[2][i] = cvtpk(s1[2 * i], s1[2 * i + 1]); pk[3][i] = cvtpk(s1[8 + 2 * i], s1[8 + 2 * i + 1]); }
}

template <int TYPE, bool BAND>
__device__ __forceinline__ void bias_mask2(f32x16& s0, f32x16& s1, const LAS float* cl, const LAS float* tbn, int kt, int qg, int qw0, int hi, unsigned long long mw) {
    const int kbase = kt * 64 + 4 * hi;
    int dbase = qg - kbase; asm volatile("" : "+v"(dbase));
    if constexpr (TYPE == 0) {
#pragma unroll
        for (int g = 0; g < 4; ++g) { const f32x4 c0 = *(const LAS f32x4*)(cl + kbase + 8 * g), c1 = *(const LAS f32x4*)(cl + kbase + 32 + 8 * g);
#pragma unroll
            for (int j = 0; j < 4; ++j) { s0[4 * g + j] -= c0[j]; s1[4 * g + j] -= c1[j]; } }
        if constexpr (BAND) {
#pragma unroll
            for (int r = 0; r < 16; ++r) { const int c = (r & 3) + 8 * (r >> 2); if (c > dbase) s0[r] = -INFINITY; if (c + 32 > dbase) s1[r] = -INFINITY; }
        }
    } else {
        const bool far = (kt * 64 + 63 + 113 <= qw0);
        if (!far) {
#pragma unroll
            for (int r = 0; r < 16; ++r) {
                const int d0 = dbase - ((r & 3) + 8 * (r >> 2)), d1 = d0 - 32;
                const float b0 = tbn[min(max(d0, 0), 127)], b1 = tbn[min(max(d1, 0), 127)];
                s0[r] = (d0 < 0) ? -INFINITY : s0[r] + b0; s1[r] = (d1 < 0) ? -INFINITY : s1[r] + b1;
                if ((r & 3) == 3) __builtin_amdgcn_sched_barrier(0);
            }
        }
        if constexpr (TYPE == 2) {
            const unsigned mlo = (unsigned)mw >> (4 * hi), mhi = (unsigned)(mw >> 32) >> (4 * hi);
#pragma unroll
            for (int r = 0; r < 16; ++r) { const int c = (r & 3) + 8 * (r >> 2); if (!((mlo >> c) & 1u)) s0[r] = -INFINITY; if (!((mhi >> c) & 1u)) s1[r] = -INFINITY; }
        }
    }
}
template <bool FENCE = true>
__device__ __forceinline__ void pv_step(f32x16 (&o)[2], const u32x4 (&pk)[4], const LAS unsigned char* vb) {
#pragma unroll
    for (int db = 0; db < 2; ++db) {
#pragma unroll
        for (int s = 0; s < 4; ++s) {
            const s16x4 lo = vtr(vb + db * 4096 + s * 1024), hh = vtr(vb + db * 4096 + s * 1024 + 512);
            const bf16x8 vf = (bf16x8){lo[0], lo[1], lo[2], lo[3], hh[0], hh[1], hh[2], hh[3]};
            o[db] = __builtin_amdgcn_mfma_f32_32x32x16_bf16(vf, __builtin_bit_cast(bf16x8, pk[s]), o[db], 0, 0, 0);
        }
        if (FENCE) __builtin_amdgcn_sched_barrier(0);
    }
}

template <int TYPE>
__device__ __forceinline__ void unit(LAS unsigned char* lds, const bf16_t* __restrict__ proj, bf16_t* __restrict__ y, const unsigned long long* __restrict__ sel,
                                     const float* __restrict__ relb, float fbias, const float* __restrict__ dlam, float lam_init, const float* __restrict__ dng, int b, int h, int qb, const int tid) {
    const int lane = tid & 63, r32 = lane & 31, hi = lane >> 5;
    const int wid = __builtin_amdgcn_readfirstlane(tid >> 6);
    constexpr int QOFF = TYPE == 0 ? C_FQ : TYPE == 1 ? C_DQ : C_SQ, KOFF = TYPE == 0 ? C_FK : TYPE == 1 ? C_DK : C_SK, VOFF = TYPE == 0 ? C_FV : TYPE == 1 ? C_DV : C_SV;
    constexpr float SCL = (TYPE == 1 ? 0.17677669529663687f : 0.125f) * LOG2E;
    const size_t rowbase = (size_t)b * SEQ; const int q0 = qb * 256; const int qw0 = q0 + 32 * wid; const int qg = qw0 + r32;
    const int NT = (qb + 1) * 4;
    LAS float* cl = (LAS float*)(lds + L_CL); LAS float* tb = (LAS float*)(lds + L_TB); LAS float* wt = (LAS float*)(lds + L_WT);
    const bf16_t* kg; const bf16_t* vg;
    { const int row = 8 * wid + (lane >> 3), c = (lane & 7) ^ ((row >> 1) & 7); kg = proj + (rowbase + row) * PW + KOFF + h * 64 + c * 8; }
    { const int row = 16 * (wid & 3) + (lane >> 2), c = (wid >> 2) * 4 + (lane & 3); vg = proj + (rowbase + row) * PW + VOFF + h * 64 + c * 8; }
    const unsigned lds0 = (unsigned)(__UINTPTR_TYPE__)lds;
#define ATT_DMA(kt_, slot_) do { const int t_ = min((kt_), NT - 1); const unsigned so_ = (unsigned)((slot_) * 8192 + wid * 1024); \
        glds16(kg + (size_t)t_ * 64 * PW, (unsigned)__builtin_amdgcn_readfirstlane((int)(lds0 + L_K + so_))); glds16(vg + (size_t)t_ * 64 * PW, (unsigned)__builtin_amdgcn_readfirstlane((int)(lds0 + L_V + so_))); } while (0)
#define ATT_WRAP(x) ((x) >= NSLOT ? (x) - NSLOT : (x))
#define ATT_WAITBAR(N) asm volatile("s_waitcnt vmcnt(" #N ") lgkmcnt(0)\n\ts_barrier" ::: "memory")
#define ATT_MWLOAD(dst, idx_) asm volatile("global_load_dwordx2 %0, %1, off" : "=v"(dst) : "v"(selp + (size_t)min((idx_), NT - 1) * SEQ) : "memory")
    const unsigned long long* selp = sel + (size_t)b * 128 * SEQ + qg;
    unsigned long long mwE = 0ull, mwO = 0ull;
    if constexpr (TYPE == 2) { ATT_MWLOAD(mwE, 0); ATT_MWLOAD(mwO, 1); }
    ATT_DMA(0, 0); ATT_DMA(1, 1); ATT_DMA(2, 2); if constexpr (TYPE != 1) ATT_DMA(3, 3);
    bf16x8 qf[4];
    { const bf16_t* qp = proj + (rowbase + qg) * PW + QOFF + h * 64 + 8 * hi;
#pragma unroll
      for (int s = 0; s < 4; ++s) { const u32x4 raw = *(const u32x4*)(qp + 16 * s); u32x4 sc;
#pragma unroll
          for (int i = 0; i < 4; ++i) sc[i] = cvtpk(__uint_as_float(raw[i] << 16) * SCL, __uint_as_float(raw[i] & 0xffff0000u) * SCL);
          qf[s] = __builtin_bit_cast(bf16x8, sc); if constexpr (TYPE == 1) *(LAS bf16x8*)(lds + L_Q + wid * 4096 + s * 1024 + lane * 16) = qf[s]; } }
    float lam = 0.f;
    if constexpr (TYPE == 0) {
        const int n = (qb + 1) * 256;
        float v[16]; float run = 0.f;
        const bf16_t* fp = proj + (rowbase + (size_t)tid * 16) * PW + C_FF + h;
#pragma unroll
        for (int i = 0; i < 16; ++i) {
            float ls = 0.f;
            if (tid * 16 + i < n) { const float x = bf2f(fp[(size_t)i * PW]) + fbias; ls = (x >= 0.f) ? -log1pf(__expf(-x)) : (x - log1pf(__expf(x))); }
            run += ls; v[i] = run;
        }
        float incl = run;
#pragma unroll
        for (int off = 1; off < 64; off <<= 1) { const float yv = __shfl_up(incl, off); if (lane >= off) incl += yv; }
        if (lane == 63) wt[wid] = incl;
        __syncthreads();
        float woff = 0.f;
        for (int w = 0; w < wid; ++w) woff += wt[w];
        const float base = incl - run + woff;
#pragma unroll
        for (int i = 0; i < 16; ++i) cl[tid * 16 + i] = (v[i] + base) * LOG2E;
    } else {
        if (tid < 128) tb[tid] = (relb[t5_bucket(tid) * 8 + (TYPE == 1 ? h : 4 + h)] - relb[31 * 8 + (TYPE == 1 ? h : 4 + h)]) * LOG2E;
        if constexpr (TYPE == 1) {
            float a = 0.f, c = 0.f;
            if (lane < 32) { a = dlam[lane] * dlam[32 + lane]; c = dlam[64 + lane] * dlam[96 + lane]; }
            a = wave_sum(a); c = wave_sum(c);
            lam = __expf(a) - __expf(c) + lam_init;
        }
    }
    asm volatile("s_waitcnt vmcnt(4)" ::: "memory");
    __syncthreads();
    const float tbfar = (TYPE == 0) ? 0.f : relb[31 * 8 + (TYPE == 1 ? h : 4 + h)] * LOG2E;
    const int xr = (r32 >> 1) & 7;
    int koff[4];
#pragma unroll
    for (int s = 0; s < 4; ++s) koff[s] = r32 * 128 + (((2 * s + hi) ^ xr) << 4);
    const int vrd = ((lane >> 4) & 1) * 32 + (lane & 3) * 8 + (4 * hi + ((lane & 15) >> 2)) * 64;
    float mA = 0.f, lA = 0.f, mB = 0.f, lB = 0.f;
    f32x16 oA[2], oB[2];
    oA[0] = f32x16{}; oA[1] = f32x16{}; oB[0] = f32x16{}; oB[1] = f32x16{};
#define ATT_TILE(kt, MWX, BAND) do { \
        const int slot = (kt) & 3; \
        unsigned long long mw = 0ull; \
        if constexpr (TYPE == 2) { asm volatile("" : "+v"(MWX)); mw = MWX; asm volatile("" : "+v"(mw)); ATT_MWLOAD(MWX, (kt) + 2); } \
        ATT_DMA((kt) + 3, ((kt) + 3) & 3); \
        const LAS unsigned char* kb = lds + L_K + slot * 8192; const LAS unsigned char* vb = lds + L_V + slot * 8192 + vrd; \
        {     \
            const float c0_ = tbfar - mA; f32x16 s0, s1; \
            _Pragma("unroll") for (int r = 0; r < 16; ++r) { s0[r] = c0_; s1[r] = c0_; } \
            _Pragma("unroll") for (int s = 0; s < (TYPE == 1 ? 2 : 4); ++s) { \
                const bf16x8 k0 = *(const LAS bf16x8*)(kb + koff[s]), k1 = *(const LAS bf16x8*)(kb + 4096 + koff[s]); \
                const bf16x8 qv = (TYPE == 1) ? *(const LAS bf16x8*)(lds + L_Q + wid * 4096 + s * 1024 + lane * 16) : qf[s]; \
                s0 = __builtin_amdgcn_mfma_f32_32x32x16_bf16(k0, qv, s0, 0, 0, 0); s1 = __builtin_amdgcn_mfma_f32_32x32x16_bf16(k1, qv, s1, 0, 0, 0); \
            } \
            __builtin_amdgcn_sched_barrier(0); \
            bias_mask2<TYPE, BAND>(s0, s1, cl, tb, (kt), qg, qw0, hi, mw); \
            __builtin_amdgcn_sched_barrier(0); \
            u32x4 pk[4]; \
            softmax2(s0, s1, mA, lA, oA, pk); \
            __builtin_amdgcn_sched_barrier(0); \
            pv_step(oA, pk, vb); \
        } \
        if constexpr (TYPE == 1) {     \
            __builtin_amdgcn_sched_barrier(0); \
            const float c0_ = tbfar - mB; f32x16 s0, s1; \
            _Pragma("unroll") for (int r = 0; r < 16; ++r) { s0[r] = c0_; s1[r] = c0_; } \
            _Pragma("unroll") for (int s = 2; s < 4; ++s) { \
                const bf16x8 k0 = *(const LAS bf16x8*)(kb + koff[s]), k1 = *(const LAS bf16x8*)(kb + 4096 + koff[s]); \
                const bf16x8 qv = *(const LAS bf16x8*)(lds + L_Q + wid * 4096 + s * 1024 + lane * 16); \
                s0 = __builtin_amdgcn_mfma_f32_32x32x16_bf16(k0, qv, s0, 0, 0, 0); s1 = __builtin_amdgcn_mfma_f32_32x32x16_bf16(k1, qv, s1, 0, 0, 0); \
            } \
            __builtin_amdgcn_sched_barrier(0); \
            bias_mask2<TYPE, BAND>(s0, s1, cl, tb, (kt), qg, qw0, hi, mw); \
            __builtin_amdgcn_sched_barrier(0); \
            u32x4 pk[4]; \
            softmax2(s0, s1, mB, lB, oB, pk); \
            __builtin_amdgcn_sched_barrier(0); \
            pv_step(oB, pk, vb); \
        } \
          \
        if constexpr (TYPE == 2) ATT_WAITBAR(5); else ATT_WAITBAR(4); \
    } while (0)
#define ATT_QK(S0, S1, kb_, mref) do { const float c0_ = tbfar - (mref); \
            _Pragma("unroll") for (int r = 0; r < 16; ++r) { S0[r] = c0_; S1[r] = c0_; } \
            _Pragma("unroll") for (int s = 0; s < 4; ++s) { \
                const bf16x8 k0 = *(const LAS bf16x8*)((kb_) + koff[s]), k1 = *(const LAS bf16x8*)((kb_) + 4096 + koff[s]); \
                S0 = __builtin_amdgcn_mfma_f32_32x32x16_bf16(k0, qf[s], S0, 0, 0, 0); S1 = __builtin_amdgcn_mfma_f32_32x32x16_bf16(k1, qf[s], S1, 0, 0, 0); } } while (0)
#define ATT_TILE2(kt, BAND) do { \
        const int slotA = sl2, slotB = sl2 + 1;        \
        unsigned long long mwa = 0ull, mwb = 0ull; \
        if constexpr (TYPE == 2) { asm volatile("" : "+v"(mwE), "+v"(mwO)); mwa = mwE; mwb = mwO; asm volatile("" : "+v"(mwa), "+v"(mwb)); ATT_MWLOAD(mwE, (kt) + 2); ATT_MWLOAD(mwO, (kt) + 3); } \
        ATT_DMA((kt) + 4, ATT_WRAP(sl2 + 4)); ATT_DMA((kt) + 5, ATT_WRAP(sl2 + 5)); \
        const LAS unsigned char* kbA = lds + L_K + slotA * 8192; const LAS unsigned char* vbA = lds + L_V + slotA * 8192 + vrd; \
        const LAS unsigned char* kbB = lds + L_K + slotB * 8192; const LAS unsigned char* vbB = lds + L_V + slotB * 8192 + vrd; \
        f32x16 a0, a1, b0, b1; \
        ATT_QK(a0, a1, kbA, mA); ATT_QK(b0, b1, kbB, mA); \
        { bias_mask2<TYPE, BAND>(a0, a1, cl, tb, (kt), qg, qw0, hi, mwa); u32x4 pk[4]; const float mold = mA; softmax2(a0, a1, mA, lA, oA, pk); \
          const float dm = mA - mold; if (__any(dm != 0.f)) { _Pragma("unroll") for (int r = 0; r < 16; ++r) { b0[r] -= dm; b1[r] -= dm; } }     \
          pv_step(oA, pk, vbA); } \
        { bias_mask2<TYPE, BAND>(b0, b1, cl, tb, (kt) + 1, qg, qw0, hi, mwb); u32x4 pk[4]; softmax2(b0, b1, mA, lA, oA, pk); pv_step(oA, pk, vbB); } \
          \
        ATT_WAITBAR(4); sl2 = ATT_WRAP(sl2 + 2); \
    } while (0)
#define SB_ __builtin_amdgcn_sched_barrier(0)
#define ATT_RDK(s_) do { kx0 = *(const LAS bf16x8*)(kbB + koff[s_]); kx1 = *(const LAS bf16x8*)(kbB + 4096 + koff[s_]); } while (0)
#define ATT_MMB(s_) do { b0 = __builtin_amdgcn_mfma_f32_32x32x16_bf16(kx0, qf[s_], b0, 0, 0, 0); b1 = __builtin_amdgcn_mfma_f32_32x32x16_bf16(kx1, qf[s_], b1, 0, 0, 0); } while (0)
#define ATT_RDV(vb_, db_, s0_) do { _Pragma("unroll") for (int i = 0; i < 2; ++i) { vl[i] = vtr((vb_) + (db_) * 4096 + ((s0_) + i) * 1024); vh[i] = vtr((vb_) + (db_) * 4096 + ((s0_) + i) * 1024 + 512); } } while (0)
#define ATT_MMV(pk_, db_, s0_) do { _Pragma("unroll") for (int i = 0; i < 2; ++i) { \
        const bf16x8 vf = (bf16x8){vl[i][0], vl[i][1], vl[i][2], vl[i][3], vh[i][0], vh[i][1], vh[i][2], vh[i][3]}; \
        oA[db_] = __builtin_amdgcn_mfma_f32_32x32x16_bf16(vf, __builtin_bit_cast(bf16x8, pk_[(s0_) + i]), oA[db_], 0, 0, 0); } } while (0)
#define ATT_BIAS(S0, S1, kt_, mw_) do { \
        if constexpr (TYPE == 0) { const int kbase = (kt_) * 64 + 4 * hi; \
            _Pragma("unroll") for (int g = 0; g < 4; ++g) { const f32x4 c0 = *(const LAS f32x4*)(cl + kbase + 8 * g), c1 = *(const LAS f32x4*)(cl + kbase + 32 + 8 * g); \
                _Pragma("unroll") for (int j = 0; j < 4; ++j) { S0[4 * g + j] -= c0[j]; S1[4 * g + j] -= c1[j]; } } \
        } else { const unsigned mlo = (unsigned)(mw_) >> (4 * hi), mhi = (unsigned)((mw_) >> 32) >> (4 * hi); \
            _Pragma("unroll") for (int r = 0; r < 16; ++r) { const int c = (r & 3) + 8 * (r >> 2); if (!((mlo >> c) & 1u)) S0[r] = -INFINITY; if (!((mhi >> c) & 1u)) S1[r] = -INFINITY; } } } while (0)
#define ATT_RMAX(rm_, S0, S1) do { float a = fmaxf(fmaxf(S0[0], S0[1]), S1[0]), c = fmaxf(fmaxf(S0[2], S0[3]), S1[1]); a = fmaxf(fmaxf(a, S1[2]), S1[3]); \
        _Pragma("unroll") for (int r = 4; r < 16; r += 4) { a = fmaxf(fmaxf(a, S0[r]), S0[r + 1]); c = fmaxf(fmaxf(c, S0[r + 2]), S0[r + 3]); a = fmaxf(fmaxf(a, S1[r]), S1[r + 1]); c = fmaxf(fmaxf(c, S1[r + 2]), S1[r + 3]); } \
        rm_ = fmaxf(a, c); rm_ = fmaxf(rm_, __shfl_xor(rm_, 32)); } while (0)
#define ATT_EXPH(S, pk0_, pk1_) do { _Pragma("unroll") for (int r = 0; r < 16; ++r) { S[r] = __builtin_amdgcn_exp2f(S[r]); rsum += S[r]; } \
        _Pragma("unroll") for (int i = 0; i < 4; ++i) { pk0_[i] = cvtpk(S[2 * i], S[2 * i + 1]); pk1_[i] = cvtpk(S[8 + 2 * i], S[8 + 2 * i + 1]); } } while (0)
#define ATT_FAST2(kt) do { \
        const int slotA = sl2, slotB = sl2 + 1; \
        unsigned long long mwa = 0ull, mwb = 0ull; \
        if constexpr (TYPE == 2) { asm volatile("" : "+v"(mwE), "+v"(mwO)); mwa = mwE; mwb = mwO; asm volatile("" : "+v"(mwa), "+v"(mwb)); ATT_MWLOAD(mwE, (kt) + 2); ATT_MWLOAD(mwO, (kt) + 3); } \
        ATT_DMA((kt) + 4, ATT_WRAP(sl2 + 4)); ATT_DMA((kt) + 5, ATT_WRAP(sl2 + 5)); \
        const LAS unsigned char* kbA = lds + L_K + slotA * 8192; const LAS unsigned char* vbA = lds + L_V + slotA * 8192 + vrd; \
        const LAS unsigned char* kbB = lds + L_K + slotB * 8192; const LAS unsigned char* vbB = lds + L_V + slotB * 8192 + vrd; \
        f32x16 a0, a1, b0, b1; u32x4 pkA[4], pkB[4]; float rma, rmb, rsum = 0.f; bf16x8 kx0, kx1; s16x4 vl[2], vh[2]; \
        ATT_RDK(0); \
        ATT_QK(a0, a1, kbA, mA); \
        { const float c0_ = tbfar - mA; _Pragma("unroll") for (int r = 0; r < 16; ++r) { b0[r] = c0_; b1[r] = c0_; } } \
        SB_; ATT_MMB(0); ATT_RDK(1); SB_; ATT_BIAS(a0, a1, (kt), mwa); SB_; ATT_MMB(1); ATT_RDK(2); SB_; ATT_RMAX(rma, a0, a1); SB_; \
        ATT_MMB(2); ATT_RDK(3); SB_; ATT_EXPH(a0, pkA[0], pkA[1]); SB_; ATT_MMB(3); ATT_RDV(vbA, 0, 0); SB_; ATT_EXPH(a1, pkA[2], pkA[3]); SB_; \
        ATT_MMV(pkA, 0, 0); ATT_RDV(vbA, 0, 2); SB_; ATT_BIAS(b0, b1, (kt) + 1, mwb); SB_; ATT_MMV(pkA, 0, 2); ATT_RDV(vbA, 1, 0); SB_; ATT_RMAX(rmb, b0, b1); SB_; \
        ATT_MMV(pkA, 1, 0); ATT_RDV(vbA, 1, 2); SB_; ATT_EXPH(b0, pkB[0], pkB[1]); SB_; ATT_MMV(pkA, 1, 2); ATT_RDV(vbB, 0, 0); SB_; ATT_EXPH(b1, pkB[2], pkB[3]); SB_; \
        ATT_MMV(pkB, 0, 0); ATT_RDV(vbB, 0, 2); SB_; ATT_MMV(pkB, 0, 2); ATT_RDV(vbB, 1, 0); SB_; ATT_MMV(pkB, 1, 0); ATT_RDV(vbB, 1, 2); SB_; ATT_MMV(pkB, 1, 2); \
        lA += rsum; \
        { const float rm = fmaxf(rma, rmb); \
          if (__any(rm > ATT_THR)) { const float d = fmaxf(rm, 0.f); mA += d; const float f = __builtin_amdgcn_exp2f(-d); lA *= f; \
              _Pragma("unroll") for (int r = 0; r < 16; ++r) { oA[0][r] *= f; oA[1][r] *= f; } } } \
        ATT_WAITBAR(4); sl2 = ATT_WRAP(sl2 + 2); \
    } while (0)
#define ATT_EXPD(S, pk0_, pk1_, rs_) do { _Pragma("unroll") for (int r = 0; r < 16; ++r) { S[r] = __builtin_amdgcn_exp2f(S[r]); rs_ += S[r]; } \
        _Pragma("unroll") for (int i = 0; i < 4; ++i) { pk0_[i] = cvtpk(S[2 * i], S[2 * i + 1]); pk1_[i] = cvtpk(S[8 + 2 * i], S[8 + 2 * i + 1]); } } while (0)
#define ATT_MMVO(O_, pk_, db_, s0_) do { _Pragma("unroll") for (int i = 0; i < 2; ++i) { \
        const bf16x8 vf = (bf16x8){vl[i][0], vl[i][1], vl[i][2], vl[i][3], vh[i][0], vh[i][1], vh[i][2], vh[i][3]}; \
        O_[db_] = __builtin_amdgcn_mfma_f32_32x32x16_bf16(vf, __builtin_bit_cast(bf16x8, pk_[(s0_) + i]), O_[db_], 0, 0, 0); } } while (0)
#define ATT_FASTD(kt) do { \
        const int slot = (kt) & 3; \
        ATT_DMA((kt) + 3, ((kt) + 3) & 3); \
        const LAS unsigned char* kb = lds + L_K + slot * 8192; const LAS unsigned char* vb = lds + L_V + slot * 8192 + vrd; \
        f32x16 a0, a1, b0, b1; u32x4 pkA[4], pkB[4]; float rma, rmb, rsa = 0.f, rsb = 0.f; bf16x8 kx0, kx1; s16x4 vl[2], vh[2]; \
        { const float ca_ = tbfar - mA, cb_ = tbfar - mB; _Pragma("unroll") for (int r = 0; r < 16; ++r) { a0[r] = ca_; a1[r] = ca_; b0[r] = cb_; b1[r] = cb_; } } \
        _Pragma("unroll") for (int s = 0; s < 2; ++s) { const bf16x8 k0 = *(const LAS bf16x8*)(kb + koff[s]), k1 = *(const LAS bf16x8*)(kb + 4096 + koff[s]); \
            a0 = __builtin_amdgcn_mfma_f32_32x32x16_bf16(k0, qf[s], a0, 0, 0, 0); a1 = __builtin_amdgcn_mfma_f32_32x32x16_bf16(k1, qf[s], a1, 0, 0, 0); } \
        kx0 = *(const LAS bf16x8*)(kb + koff[2]); kx1 = *(const LAS bf16x8*)(kb + 4096 + koff[2]); \
        SB_; b0 = __builtin_amdgcn_mfma_f32_32x32x16_bf16(kx0, qf[2], b0, 0, 0, 0); b1 = __builtin_amdgcn_mfma_f32_32x32x16_bf16(kx1, qf[2], b1, 0, 0, 0); \
        kx0 = *(const LAS bf16x8*)(kb + koff[3]); kx1 = *(const LAS bf16x8*)(kb + 4096 + koff[3]); SB_; ATT_RMAX(rma, a0, a1); SB_; \
        b0 = __builtin_amdgcn_mfma_f32_32x32x16_bf16(kx0, qf[3], b0, 0, 0, 0); b1 = __builtin_amdgcn_mfma_f32_32x32x16_bf16(kx1, qf[3], b1, 0, 0, 0); ATT_RDV(vb, 0, 0); SB_; ATT_EXPD(a0, pkA[0], pkA[1], rsa); SB_; \
        ATT_MMVO(oA, pkA, 0, 0); ATT_RDV(vb, 1, 0); SB_; ATT_EXPD(a1, pkA[2], pkA[3], rsa); SB_; \
        ATT_MMVO(oA, pkA, 1, 0); ATT_RDV(vb, 0, 2); SB_; ATT_RMAX(rmb, b0, b1); SB_; \
        ATT_MMVO(oA, pkA, 0, 2); ATT_RDV(vb, 1, 2); SB_; ATT_EXPD(b0, pkB[0], pkB[1], rsb); SB_; \
        ATT_MMVO(oA, pkA, 1, 2); ATT_RDV(vb, 0, 0); SB_; ATT_EXPD(b1, pkB[2], pkB[3], rsb); SB_; \
        ATT_MMVO(oB, pkB, 0, 0); ATT_RDV(vb, 0, 2); SB_; ATT_MMVO(oB, pkB, 0, 2); ATT_RDV(vb, 1, 0); SB_; ATT_MMVO(oB, pkB, 1, 0); ATT_RDV(vb, 1, 2); SB_; ATT_MMVO(oB, pkB, 1, 2); \
        lA += rsa; lB += rsb; \
        if (__any(rma > ATT_THR)) { const float d = fmaxf(rma, 0.f); mA += d; const float f = __builtin_amdgcn_exp2f(-d); lA *= f; \
            _Pragma("unroll") for (int r = 0; r < 16; ++r) { oA[0][r] *= f; oA[1][r] *= f; } } \
        if (__any(rmb > ATT_THR)) { const float d = fmaxf(rmb, 0.f); mB += d; const float f = __builtin_amdgcn_exp2f(-d); lB *= f; \
            _Pragma("unroll") for (int r = 0; r < 16; ++r) { oB[0][r] *= f; oB[1][r] *= f; } } \
        ATT_WAITBAR(4); \
    } while (0)
    int sl2 = 0;
    if constexpr (TYPE == 1) { const int nfarT = (q0 >= 176) ? ((q0 - 176) >> 6) + 1 : 0;
        int kt = 0; for (; kt < nfarT; ++kt) { ATT_FASTD(kt); } for (; kt < NT - 4; ++kt) { ATT_TILE(kt, mwE, false); } for (; kt < NT; ++kt) { ATT_TILE(kt, mwE, true); } }
    else if constexpr (TYPE == 0) { for (int kt = 0; kt < NT - 4; kt += 2) { ATT_FAST2(kt); } ATT_TILE2(NT - 4, true); ATT_TILE2(NT - 2, true); }
    else { const int nfarT = (q0 >= 176) ? ((q0 - 176) >> 6) + 1 : 0;
           int kt = 0; for (; kt + 2 <= nfarT; kt += 2) { ATT_FAST2(kt); } for (; kt < NT; kt += 2) { ATT_TILE2(kt, false); } }
    asm volatile("s_waitcnt vmcnt(0)" ::: "memory");
#undef ATT_TILE
#undef ATT_TILE2
#undef ATT_FASTD
#undef ATT_EXPD
#undef ATT_MMVO
#undef ATT_FAST2
#undef ATT_RDK
#undef ATT_MMB
#undef ATT_RDV
#undef ATT_MMV
#undef ATT_BIAS
#undef ATT_RMAX
#undef ATT_EXPH
#undef SB_
#undef ATT_QK
#undef ATT_DMA
#undef ATT_WAITBAR
#undef ATT_WRAP
#undef ATT_MWLOAD
    lA += __shfl_xor(lA, 32); const float iA = 1.0f / lA;
    bf16_t* yp = y + (rowbase + qg) * 1024 + TYPE * 256 + h * 64 + 4 * hi;
    if constexpr (TYPE == 1) {
        lB += __shfl_xor(lB, 32); const float iB = lam / lB;
        float ss = 0.f;
#pragma unroll
        for (int db = 0; db < 2; ++db)
#pragma unroll
            for (int r = 0; r < 16; ++r) { const float v = oA[db][r] * iA - oB[db][r] * iB; oA[db][r] = v; ss += v * v; }
        ss += __shfl_xor(ss, 32);
        const float rn = rsqrtf(ss * (1.0f / 64.0f) + LN_EPS) * (1.0f - lam_init);
#pragma unroll
        for (int db = 0; db < 2; ++db)
#pragma unroll
            for (int g = 0; g < 4; ++g) { const f32x4 gv = *(const f32x4*)(dng + db * 32 + 8 * g + 4 * hi);
                u32x2 w; w.x = cvtpk(oA[db][4 * g] * rn * gv[0], oA[db][4 * g + 1] * rn * gv[1]); w.y = cvtpk(oA[db][4 * g + 2] * rn * gv[2], oA[db][4 * g + 3] * rn * gv[3]);
                *(u32x2*)(yp + db * 32 + 8 * g) = w; }
    } else {
#pragma unroll
        for (int db = 0; db < 2; ++db)
#pragma unroll
            for (int g = 0; g < 4; ++g) { u32x2 w; w.x = cvtpk(oA[db][4 * g] * iA, oA[db][4 * g + 1] * iA); w.y = cvtpk(oA[db][4 * g + 2] * iA, oA[db][4 * g + 3] * iA);
                *(u32x2*)(yp + db * 32 + 8 * g) = w; }
    }
    __syncthreads();
}
}

namespace idx {
constexpr int IDX_KST = 73728;
__device__ __forceinline__ unsigned key16(float v) { v = v + 0.0f; const unsigned x = (unsigned)__builtin_bit_cast(unsigned short, (_Float16)v); return x ^ ((x & 0x8000u) ? 0xffffu : 0x8000u); }

__device__ __forceinline__ void topk_query(const unsigned short* __restrict__ srow, int q, LAS unsigned* kq, LAS unsigned* hist, unsigned long long& w0, unsigned long long& w1, int lane) {
    const int nreg = (q >> 7) + 1;
    const unsigned c3 = (unsigned)lane % 3u;
#pragma unroll
    for (int i = 0; i < 3; ++i) *(LAS u32x4*)(hist + lane * 12 + i * 4) = (u32x4){0u, 0u, 0u, 0u};
    LDS_WAIT();
    const __amdgpu_buffer_rsrc_t rsrc = __builtin_amdgcn_make_buffer_rsrc((void*)srow, 0, 8192 * 2, 0x00020000);
    for (int j0 = 0; j0 < nreg; j0 += 8) {
        unsigned w[8];
#pragma unroll
        for (int i = 0; i < 8; ++i) w[i] = __builtin_amdgcn_raw_buffer_load_b32(rsrc, lane * 4 + (j0 + i) * 256, 0, 0);
#pragma unroll
        for (int i = 0; i < 8; ++i) { const int j = j0 + i;
            const unsigned lo = (lane + 128 * j <= q) ? (w[i] & 0xffffu) : 0u, hi = (lane + 128 * j + 64 <= q) ? (w[i] & 0xffff0000u) : 0u;
            if (j < 64) kq[64 * j + lane] = lo | hi;
            if (lo) __hip_atomic_fetch_add(hist + (lo >> 8) * 3u + c3, 1u, __ATOMIC_RELAXED, __HIP_MEMORY_SCOPE_WORKGROUP);
            if (hi) __hip_atomic_fetch_add(hist + (hi >> 24) * 3u + c3, 1u, __ATOMIC_RELAXED, __HIP_MEMORY_SCOPE_WORKGROUP); }
    }
    unsigned need = 256u, prefix = 0u;
#pragma unroll 1
    for (int pass = 0; pass < 2; ++pass) {
        if (pass == 1) {
#pragma unroll
            for (int i = 0; i < 3; ++i) *(LAS u32x4*)(hist + lane * 12 + i * 4) = (u32x4){0u, 0u, 0u, 0u};
            LDS_WAIT();
            for (int j0 = 0; j0 < nreg; j0 += 4) { unsigned w[4];
#pragma unroll
                for (int i = 0; i < 4; ++i) w[i] = kq[64 * (j0 + i) + lane];
#pragma unroll
                for (int i = 0; i < 4; ++i) { const unsigned wv = (j0 + i < nreg) ? w[i] : 0u; const unsigned lo = wv & 0xffffu, hi = wv >> 16;
                    if ((lo >> 8) == prefix) __hip_atomic_fetch_add(hist + (lo & 255u) * 3u + c3, 1u, __ATOMIC_RELAXED, __HIP_MEMORY_SCOPE_WORKGROUP);
                    if ((hi >> 8) == prefix) __hip_atomic_fetch_add(hist + (hi & 255u) * 3u + c3, 1u, __ATOMIC_RELAXED, __HIP_MEMORY_SCOPE_WORKGROUP); } }
        }
        LDS_WAIT();
        u32x4 cv;
        { const u32x4 h0 = *(const LAS u32x4*)(hist + lane * 12), h1 = *(const LAS u32x4*)(hist + lane * 12 + 4), h2 = *(const LAS u32x4*)(hist + lane * 12 + 8);
          cv[0] = h0[0] + h0[1] + h0[2]; cv[1] = h0[3] + h1[0] + h1[1]; cv[2] = h1[2] + h1[3] + h2[0]; cv[3] = h2[1] + h2[2] + h2[3]; }
        const unsigned tot = (cv[0] + cv[1]) + (cv[2] + cv[3]);
        unsigned incl = tot;
#pragma unroll
        for (int off = 1; off < 64; off <<= 1) { const unsigned yv = __shfl_down(incl, off); if (lane + off < 64) incl += yv; }
        const unsigned a3 = incl - tot, a2 = a3 + cv[3], a1 = a2 + cv[2], a0 = a1 + cv[1];
        int dsel = -1; unsigned ab = 0u;
        if (a3 < need && a3 + cv[3] >= need) { dsel = 4 * lane + 3; ab = a3; }
        else if (a2 < need && a2 + cv[2] >= need) { dsel = 4 * lane + 2; ab = a2; }
        else if (a1 < need && a1 + cv[1] >= need) { dsel = 4 * lane + 1; ab = a1; }
        else if (a0 < need && a0 + cv[0] >= need) { dsel = 4 * lane + 0; ab = a0; }
        const unsigned long long fm = __ballot(dsel >= 0);
        const int src = fm ? (__ffsll((long long)fm) - 1) : 0;
        const unsigned dd = (unsigned)__shfl(dsel, src) & 255u, abb = (unsigned)__shfl((int)ab, src);
        need -= abb; prefix = (prefix << 8) | dd;
        LDS_WAIT();
    }
    LAS unsigned long long* wout = (LAS unsigned long long*)hist;
    *(LAS u32x4*)(hist + lane * 4) = (u32x4){0u, 0u, 0u, 0u};
    LDS_WAIT();
    unsigned run_eq = 0u;
    const unsigned long long ltmask = (lane == 0) ? 0ull : (~0ull >> (64 - lane));
    for (int j0 = 0; j0 < nreg; j0 += 4) { unsigned w[4];
#pragma unroll
        for (int i = 0; i < 4; ++i) w[i] = kq[64 * (j0 + i) + lane];
#pragma unroll
        for (int i = 0; i < 4; ++i) { const int j = j0 + i; const unsigned wv = (j < nreg) ? w[i] : 0u; const unsigned lo = wv & 0xffffu, hi = wv >> 16;
            unsigned long long sl = __ballot(lo > prefix), sh = __ballot(hi > prefix);
            const unsigned long long el = __ballot(lo == prefix), eh = __ballot(hi == prefix);
            if (el | eh) {
                const unsigned rl = run_eq + (unsigned)__popcll(el & ltmask); run_eq += (unsigned)__popcll(el);
                const unsigned rh = run_eq + (unsigned)__popcll(eh & ltmask); run_eq += (unsigned)__popcll(eh);
                sl |= __ballot((lo == prefix) && rl < need); sh |= __ballot((hi == prefix) && rh < need);
            }
            if (lane == 0 && j < 64) { wout[2 * j] = sl; wout[2 * j + 1] = sh; } } }
    LDS_WAIT();
    w0 = wout[lane]; w1 = wout[64 + lane];
    LDS_WAIT();
}

__device__ __forceinline__ void tile(LAS unsigned char* lds, const bf16_t* __restrict__ proj, unsigned short* __restrict__ scr, unsigned long long* __restrict__ sel, int b, int jt, const int tid_) {
    int tid = tid_; asm volatile("" : "+v"(tid));
    const int lane = tid & 63, r32 = lane & 31, hi = lane >> 5;
    const int wid = __builtin_amdgcn_readfirstlane(tid >> 6);
    const size_t rowbase = (size_t)b * SEQ; const int q0 = jt * 32; const int g = wid & 3, p = wid >> 2;
    if (q0 >= 256) {
        bf16x8 af[4];
        { const bf16_t* ap = proj + (rowbase + q0 + 8 * g + (r32 >> 2)) * PW + C_IQ + (r32 & 3) * 64 + 8 * hi;
#pragma unroll
          for (int s = 0; s < 4; ++s) af[s] = *(const bf16x8*)(ap + 16 * s); }
        float cw[16];
#pragma unroll
        for (int r = 0; r < 16; ++r) cw[r] = bf2f(proj[(rowbase + q0 + 8 * g + 2 * (r >> 2) + hi) * PW + C_IW + (r & 3)]) * 0.0625f;
        const int nkt = jt + 1;
        const int nround = (nkt + 3) >> 2;
        const unsigned lds0 = (unsigned)(__UINTPTR_TYPE__)lds;
        const bf16_t* dsrc; const bf16_t* dsrc2;
        { const int row = 16 * wid + (lane >> 3), c = (lane & 7) ^ ((row >> 1) & 7), c2 = (lane & 7) ^ (((row + 8) >> 1) & 7);
          dsrc = proj + (rowbase + row) * PW + C_IK + c * 8; dsrc2 = proj + (rowbase + row + 8) * PW + C_IK + c2 * 8; }
#define IDX_DMA(rnd) do { const int rc_ = min((rnd), nround - 1); const unsigned so_ = lds0 + (unsigned)(((rnd) & 3) * 16384 + wid * 2048); \
        glds16(dsrc + (size_t)rc_ * 128 * PW, (unsigned)__builtin_amdgcn_readfirstlane((int)so_)); glds16(dsrc2 + (size_t)rc_ * 128 * PW, (unsigned)__builtin_amdgcn_readfirstlane((int)(so_ + 1024u))); } while (0)
        const int frow = p * 32 + r32;
        int frd[4];
#pragma unroll
        for (int s = 0; s < 4; ++s) frd[s] = frow * 128 + (((2 * s + hi) ^ ((frow >> 1) & 7)) << 4);
        IDX_DMA(0); IDX_DMA(1); IDX_DMA(2);
        asm volatile("s_waitcnt vmcnt(4)\n\ts_barrier" ::: "memory");
        for (int rnd = 0; rnd < nround; ++rnd) {
            IDX_DMA(rnd + 3);
            const LAS unsigned char* kb = lds + (rnd & 3) * 16384;
            f32x16 acca = f32x16{}, accb = f32x16{};
#pragma unroll
            for (int s = 0; s < 4; ++s) { acca = __builtin_amdgcn_mfma_f32_32x32x16_bf16(af[s], *(const LAS bf16x8*)(kb + frd[s]), acca, 0, 0, 0);
                                          accb = __builtin_amdgcn_mfma_f32_32x32x16_bf16(af[s], *(const LAS bf16x8*)(kb + 8192 + frd[s]), accb, 0, 0, 0); }
            const int dw = 64 * rnd + 32 * p + r32;
#pragma unroll
            for (int qi = 0; qi < 4; ++qi) {
                float sa = 0.f, sb = 0.f;
#pragma unroll
                for (int hh = 0; hh < 4; ++hh) { sa += cw[4 * qi + hh] * fmaxf(acca[4 * qi + hh], 0.f); sb += cw[4 * qi + hh] * fmaxf(accb[4 * qi + hh], 0.f); }
                ((unsigned*)scr)[(size_t)(8 * g + 2 * qi + hi) * 4096 + dw] = key16(sa) | (key16(sb) << 16);
            }
            if (rnd == 0) asm volatile("s_waitcnt vmcnt(8) lgkmcnt(0)\n\ts_barrier" ::: "memory");
            else if (rnd == 1) asm volatile("s_waitcnt vmcnt(12) lgkmcnt(0)\n\ts_barrier" ::: "memory");
            else asm volatile("s_waitcnt vmcnt(16) lgkmcnt(0)\n\ts_barrier" ::: "memory");
        }
        asm volatile("s_waitcnt vmcnt(0)" ::: "memory");
#undef IDX_DMA
    }
    __syncthreads();
    LAS unsigned* kq = (LAS unsigned*)lds + wid * 4096;
    LAS unsigned* hist = (LAS unsigned*)(lds + 135168) + wid * 768;
    unsigned long long wa[4], wb[4];
    if (q0 < 256) {
#pragma unroll
        for (int i = 0; i < 4; ++i) {
            const int q = q0 + 4 * wid + i;
            const int nb0 = q + 1 - 64 * lane;
            wa[i] = nb0 >= 64 ? ~0ull : (nb0 <= 0 ? 0ull : ((1ull << nb0) - 1ull)); wb[i] = 0ull;
        }
    } else {
#pragma unroll
        for (int i = 0; i < 4; ++i) { const int ql = 4 * wid + i, q = q0 + ql; topk_query(scr + (size_t)ql * 8192, q, kq, hist, wa[i], wb[i], lane); }
    }
    { unsigned long long* d0 = sel + ((size_t)b * 128 + lane) * SEQ + q0 + 4 * wid; unsigned long long* d1 = d0 + (size_t)64 * SEQ;
      *(u32x4*)d0 = (u32x4){(unsigned)wa[0], (unsigned)(wa[0] >> 32), (unsigned)wa[1], (unsigned)(wa[1] >> 32)}; *(u32x4*)(d0 + 2) = (u32x4){(unsigned)wa[2], (unsigned)(wa[2] >> 32), (unsigned)wa[3], (unsigned)(wa[3] >> 32)};
      *(u32x4*)d1 = (u32x4){(unsigned)wb[0], (unsigned)(wb[0] >> 32), (unsigned)wb[1], (unsigned)(wb[1] >> 32)}; *(u32x4*)(d1 + 2) = (u32x4){(unsigned)wb[2], (unsigned)(wb[2] >> 32), (unsigned)wb[3], (unsigned)(wb[3] >> 32)}; }
    __syncthreads();
}
}

__device__ __forceinline__ void conv_tile(LAS unsigned char* lds, const bf16_t* __restrict__ proj, bf16_t* __restrict__ y, const float* __restrict__ cwt, const float* __restrict__ cb,
                                          const float* __restrict__ lg, const float* __restrict__ lb, int b, int t0, const int tid) {
    const int lane = tid & 63; const int wid = __builtin_amdgcn_readfirstlane(tid >> 6);
    LAS float* hb = (LAS float*)lds;
    LAS float* ob = (LAS float*)(lds + 65536);
    const size_t rowbase = (size_t)b * SEQ;
    for (int idx = tid; idx < 62 * 32; idx += NTHR) {
        const int rr = idx >> 5, c8 = (idx & 31) * 8, t = t0 - 30 + rr;
        f32x4 h0 = {0.f, 0.f, 0.f, 0.f}, h1 = {0.f, 0.f, 0.f, 0.f};
        if (t >= 0) { const bf16_t* p = proj + (rowbase + t) * PW + C_CU + c8; const u32x4 av = *(const u32x4*)p, gv = *(const u32x4*)(p + 256);
#pragma unroll
            for (int i = 0; i < 2; ++i) { h0[2 * i] = __uint_as_float(av[i] << 16) * sigmoidf_(__uint_as_float(gv[i] << 16)); h0[2 * i + 1] = __uint_as_float(av[i] & 0xffff0000u) * sigmoidf_(__uint_as_float(gv[i] & 0xffff0000u));
                                          h1[2 * i] = __uint_as_float(av[2 + i] << 16) * sigmoidf_(__uint_as_float(gv[2 + i] << 16)); h1[2 * i + 1] = __uint_as_float(av[2 + i] & 0xffff0000u) * sigmoidf_(__uint_as_float(gv[2 + i] & 0xffff0000u)); } }
        *(LAS f32x4*)(hb + rr * 256 + c8) = h0; *(LAS f32x4*)(hb + rr * 256 + c8 + 4) = h1;
    }
    __syncthreads();
    { const int c = tid & 255, half = tid >> 8;
      float w[31], win[46];
#pragma unroll
      for (int j = 0; j < 31; ++j) w[j] = cwt[j * 256 + c];
      const float bias = cb[c];
#pragma unroll
      for (int j = 0; j < 46; ++j) win[j] = hb[(half * 16 + j) * 256 + c];
#pragma unroll
      for (int i = 0; i < 16; ++i) {
          float a = bias;
#pragma unroll
          for (int j = 0; j < 31; ++j) a += w[j] * win[i + j];
          ob[(half * 16 + i) * 256 + c] = a;
      } }
    __syncthreads();
    for (int i = 0; i < 4; ++i) {
        const int tt = wid * 4 + i;
        const f32x4 v = *(const LAS f32x4*)(ob + tt * 256 + lane * 4);
        const float mean = wave_sum((v[0] + v[1]) + (v[2] + v[3])) * (1.0f / 256.0f);
        const f32x4 d = v - mean;
        const float var = wave_sum((d[0] * d[0] + d[1] * d[1]) + (d[2] * d[2] + d[3] * d[3])) * (1.0f / 256.0f);
        const float rstd = rsqrtf(var + LN_EPS);
        const f32x4 gv = *(const f32x4*)(lg + lane * 4), bv = *(const f32x4*)(lb + lane * 4);
        float o[4];
#pragma unroll
        for (int j = 0; j < 4; ++j) { const float z = d[j] * rstd * gv[j] + bv[j]; o[j] = z * sigmoidf_(z); }
        u32x2 w2; w2.x = cvtpk(o[0], o[1]); w2.y = cvtpk(o[2], o[3]);
        *(u32x2*)(y + (rowbase + t0 + tt) * 1024 + 768 + lane * 4) = w2;
    }
    __syncthreads();
}

__device__ __forceinline__ void cvt_item(const float* __restrict__ src, int ldn, int ncol, bool valid, bf16_t* __restrict__ dtile, int k0, LAS unsigned char* wl, int lane) {
    float v[64];
#pragma unroll
    for (int j = 0; j < 64; ++j) v[j] = valid ? __builtin_nontemporal_load(src + (size_t)(k0 + j) * ldn + ncol) : 0.f;
#pragma unroll
    for (int c = 0; c < 8; ++c) { u32x4 w; w.x = cvtpk(v[8 * c], v[8 * c + 1]); w.y = cvtpk(v[8 * c + 2], v[8 * c + 3]); w.z = cvtpk(v[8 * c + 4], v[8 * c + 5]); w.w = cvtpk(v[8 * c + 6], v[8 * c + 7]);
        *(LAS u32x4*)(wl + lane * 144 + c * 16) = w; }
    LDS_WAIT();
#pragma unroll
    for (int i = 0; i < 8; ++i) { const int row = (lane >> 3) + 8 * i, ch = lane & 7; const u32x4 w = *(const LAS u32x4*)(wl + row * 144 + ch * 16);
        __builtin_nontemporal_store(w, (u32x4*)(dtile + (size_t)row * 1024 + k0 + ch * 8)); }
    LDS_WAIT();
}
__device__ __forceinline__ int win_src_col(int n) {
    if (n < 768) return n;
    if (n < 2624) return n + 4;
    if (n < 3136) return n + 8;
    if (n < 3140) return 768 + (n - 3136);
    if (n < 3144) return 2628 + (n - 3140);
    return -1;
}
constexpr int CV_I_GU = 32 * 16, CV_I_DN = 16 * 16, CV_ITEMS = NE * (CV_I_GU + CV_I_DN), CV_CH = 32, CV_NCH = CV_ITEMS / CV_CH, CV_TOTAL = DEPTH * CV_NCH, CW_CVQ = CW_Q + 40 * 64;
__device__ __forceinline__ void cvx_ptrs(int r, int lx, const float* __restrict__ w_gu, const float* __restrict__ w_down, bf16_t* __restrict__ WGU, bf16_t* __restrict__ WDN, int lane, const float*& src, int& ldn, bf16_t*& dst) {
    if (r < NE * CV_I_GU) { const int le = lx * NE + r / CV_I_GU, q = r % CV_I_GU, kb = q / 32, nb = q % 32; ldn = 2048;
        src = w_gu + ((size_t)le * 1024 + kb * 64) * 2048 + nb * 64; dst = WGU + ((size_t)le * 2048 + nb * 64) * 1024 + kb * 64; }
    else { r -= NE * CV_I_GU; const int le = lx * NE + r / CV_I_DN, q = r % CV_I_DN, kb = q / 16, nb = q % 16; ldn = 1024;
        src = w_down + ((size_t)le * 1024 + kb * 64) * 1024 + nb * 64; dst = WDN + ((size_t)le * 1024 + nb * 64) * 1024 + kb * 64; }
    src += (size_t)(16 * (lane >> 4)) * ldn + 4 * (lane & 15);
}
__device__ __forceinline__ void cvx_load(f32x4 (&v)[16], const float* __restrict__ p, int ldn) {
#pragma unroll
    for (int j = 0; j < 16; ++j) v[j] = __builtin_nontemporal_load((const f32x4*)(p + (size_t)j * ldn));
}
__device__ __forceinline__ void cvx_store(const f32x4 (&v)[16], bf16_t* __restrict__ dtile, LAS unsigned char* wl, int lane) {
    const int r4 = lane >> 4, c4 = lane & 15;
#pragma unroll
    for (int i = 0; i < 4; ++i) { u32x4 w0, w1;
        w0.x = cvtpk(v[0][i], v[1][i]); w0.y = cvtpk(v[2][i], v[3][i]); w0.z = cvtpk(v[4][i], v[5][i]); w0.w = cvtpk(v[6][i], v[7][i]);
        w1.x = cvtpk(v[8][i], v[9][i]); w1.y = cvtpk(v[10][i], v[11][i]); w1.z = cvtpk(v[12][i], v[13][i]); w1.w = cvtpk(v[14][i], v[15][i]);
        *(LAS u32x4*)(wl + (4 * c4 + i) * 144 + r4 * 32) = w0; *(LAS u32x4*)(wl + (4 * c4 + i) * 144 + r4 * 32 + 16) = w1; }
    LDS_WAIT();
#pragma unroll
    for (int i = 0; i < 8; ++i) { const int row = (lane >> 3) + 8 * i, ch = lane & 7; const u32x4 w = *(const LAS u32x4*)(wl + row * 144 + ch * 16);
        __builtin_nontemporal_store(w, (u32x4*)(dtile + (size_t)row * 1024 + ch * 8)); }
    LDS_WAIT();
}
__device__ __forceinline__ void cvx_chunk(int ch, const float* __restrict__ w_gu, const float* __restrict__ w_down, bf16_t* __restrict__ WGU, bf16_t* __restrict__ WDN, LAS unsigned char* wl, int wid, int lane) {
    const int lx = ch / CV_NCH, r0 = (ch % CV_NCH) * CV_CH + wid;
    const float* s0; const float* s1; bf16_t* d0; bf16_t* d1; int l0, l1;
    f32x4 va[16], vb[16];
    cvx_ptrs(r0, lx, w_gu, w_down, WGU, WDN, lane, s0, l0, d0); cvx_load(va, s0, l0);
    cvx_ptrs(r0 + NWAVES, lx, w_gu, w_down, WGU, WDN, lane, s1, l1, d1); cvx_load(vb, s1, l1);
    cvx_store(va, d0, wl, lane);
    cvx_ptrs(r0 + 2 * NWAVES, lx, w_gu, w_down, WGU, WDN, lane, s0, l0, d0); cvx_load(va, s0, l0);
    cvx_store(vb, d1, wl, lane);
    cvx_ptrs(r0 + 3 * NWAVES, lx, w_gu, w_down, WGU, WDN, lane, s1, l1, d1); cvx_load(vb, s1, l1);
    cvx_store(va, d0, wl, lane);
    cvx_store(vb, d1, wl, lane);
}

#ifndef PH_MASK
#define PH_MASK 0xFFFF
#endif
#define PHASE_ON(n) ((PH_MASK >> (n)) & 1)
#ifndef REPEAT_MASK
#define REPEAT_MASK 0
#endif
#define NREP(n) (1 + ((REPEAT_MASK >> (n)) & 1))
struct Args { const float* in[21]; float* out; unsigned char* ws; };

__device__ __forceinline__ int q_fetch(unsigned* ctr, volatile LAS int* bc, int tid) {
    __syncthreads();
    if (tid == 0) *bc = (int)__hip_atomic_fetch_add(ctr, 1u, __ATOMIC_RELAXED, __HIP_MEMORY_SCOPE_AGENT);
    __syncthreads();
    return __builtin_amdgcn_readfirstlane(*bc);
}

__device__ __forceinline__ int q_fetch_lim(unsigned* ctr, volatile LAS int* bc, int tid, unsigned limit) {
    __syncthreads();
    if (tid == 0) { const unsigned cur = __hip_atomic_load(ctr, __ATOMIC_RELAXED, __HIP_MEMORY_SCOPE_AGENT); *bc = (cur < limit) ? (int)__hip_atomic_fetch_add(ctr, 1u, __ATOMIC_RELAXED, __HIP_MEMORY_SCOPE_AGENT) : 0x7fffffff; }
    __syncthreads();
    return __builtin_amdgcn_readfirstlane(*bc);
}
#define CVT_CHUNK(ch_) cvx_chunk((ch_), IN(15), IN(17), (bf16_t*)(ws + WS_WGU), (bf16_t*)(ws + WS_WDN), lds + wid * 9216, wid, lane)

typedef const __attribute__((address_space(4))) Args* ArgsP;
#define PHASE_PTRS() ArgsP ap_ = (ArgsP)__builtin_amdgcn_kernarg_segment_ptr(); asm volatile("" : "+s"(ap_)); unsigned char* ws = ap_->ws; unsigned* ctl = (unsigned*)(ws + WS_CTL); (void)ctl; int tid = wid0 * 64 + lane_id_(); asm volatile("" : "+v"(tid)); const int lane = tid & 63; const int wid = __builtin_amdgcn_readfirstlane(tid >> 6); (void)lane; (void)wid
#define IN(i) (ap_->in[i])

template <int layer>
__device__ __forceinline__ void run_layer(LAS unsigned char* lds, const XcdBarrier& bar, volatile LAS int* qbc, const int G, const int bid, const int wid0) {
        const float lam_init = (layer == 0) ? 0.2f : (layer == 1) ? 0.35550906759096934f : (layer == 2) ? 0.4707130183435842f : 0.5560582041556406f;
        _Pragma("unroll") for (int rep = 0; rep < NREP(1); ++rep) {
        PROBE_T0(1);
#if PHASE_ON(1)
    asm volatile("; PHASE_MARK 1");
        {
            PHASE_PTRS();
            pg8::DenseSched S; S.init((const bf16_t*)(ws + WS_XB), (const bf16_t*)(ws + WS_WIN) + (size_t)layer * PW * 1024, T, PW, G, bid);
            pg8::EpiProj E{(bf16_t*)(ws + WS_PROJ)};
            pg8::gemm_phase<pg8::EpiProj, pg8::DenseSched, true>(lds, S, E, tid);
            { constexpr int NU = (T / 256) * (PW / 256); if (NU % G != 0 && bid >= NU % G) { const int ch = q_fetch_lim(ctl + CW_CVQ, qbc, tid, CV_TOTAL); if (ch < CV_TOTAL) CVT_CHUNK(ch); } }
        }
#endif
        xcd_barrier(bar, wid0);
        PROBE_SPIN(1);
        }
        _Pragma("unroll") for (int rep = 0; rep < NREP(2); ++rep) {
        PROBE_T0(2);
#if PHASE_ON(2)
    asm volatile("; PHASE_MARK 2");
        {
            PHASE_PTRS();
            const bf16_t* PROJ = (const bf16_t*)(ws + WS_PROJ); bf16_t* Y = (bf16_t*)(ws + WS_Y); unsigned long long* SEL = (unsigned long long*)(ws + WS_SEL); unsigned short* SCR = (unsigned short*)(ws + WS_SCR) + (size_t)bid * 32 * 8192;
            const float* conv_w = IN(6); const float* conv_b = IN(7); const float* conv_ln_g = IN(8); const float* conv_ln_b = IN(9);
            { PROBE_T0(9);
            for (int u2 = bid * 2; u2 < 512; u2 += (u2 & 1) ? (2 * G - 1) : 1) { const int u = u2 >> 1, b = u >> 7, j = u & 127; idx::tile(lds, PROJ, SCR, SEL, b, (u2 & 1) ? 255 - j : j, tid); }
            PROBE_SPIN(9); }
            { PROBE_T0(10);
            for (int u = bid; u < T / 32; u += G) { const int b = u / (SEQ / 32), t0 = (u % (SEQ / 32)) * 32;
                conv_tile(lds, PROJ, Y, conv_w + (size_t)layer * 31 * 256, conv_b + layer * 256, conv_ln_g + layer * 256, conv_ln_b + layer * 256, b, t0, tid); }
            PROBE_SPIN(10); }
        }
#endif
        xcd_barrier(bar, wid0);
        PROBE_SPIN(2);
        }
        _Pragma("unroll") for (int rep = 0; rep < NREP(3); ++rep) {
        PROBE_T0(3);
#if PHASE_ON(3)
    asm volatile("; PHASE_MARK 3");
        {
            PHASE_PTRS();
            const bf16_t* PROJ = (const bf16_t*)(ws + WS_PROJ); bf16_t* Y = (bf16_t*)(ws + WS_Y); const unsigned long long* SEL = (const unsigned long long*)(ws + WS_SEL);
            const float* rel_bias = IN(1); const float* forget_b = IN(3); const float* diff_lambda = IN(4); const float* diff_norm_g = IN(5);
#ifndef ATT_MASK
#define ATT_MASK 7
#endif
            bool cvt_more = true;
            const int xq_ = (G % 8 == 0) ? 1 + (bid & 7) : 0, xn_ = (G % 8 == 0) ? 32 : 256;
#define CVT_STEP() do { if (cvt_more) { const int ch_ = q_fetch_lim(ctl + CW_CVQ, qbc, tid, CV_TOTAL); if (ch_ < CV_TOTAL) CVT_CHUNK(ch_); else cvt_more = false; } } while (0)
            if (ATT_MASK & 4) for (;;) { int u = q_fetch(ctl + CW_Q + (layer * 8 + 2 + 4 * rep) * 64 + xq_, qbc, tid); if (u >= xn_) break; if (xn_ == 32) u = u * 8 + (bid & 7); const int qb = 31 - (u >> 3), b = (u >> 2) & 1, h = u & 3;
                att::unit<2>(lds, PROJ, Y, SEL, rel_bias, 0.f, nullptr, 0.f, nullptr, b, h, qb, tid); CVT_STEP(); }
            if (ATT_MASK & 1) for (;;) { int u = q_fetch(ctl + CW_Q + (layer * 8 + 0 + 4 * rep) * 64 + xq_, qbc, tid); if (u >= xn_) break; if (xn_ == 32) u = u * 8 + (bid & 7); const int qb = 31 - (u >> 3), b = (u >> 2) & 1, h = u & 3;
                att::unit<1>(lds, PROJ, Y, SEL, rel_bias, 0.f, diff_lambda + layer * 128, lam_init, diff_norm_g + layer * 64, b, h, qb, tid); CVT_STEP(); }
            if (ATT_MASK & 2) for (;;) { int u = q_fetch(ctl + CW_Q + (layer * 8 + 1 + 4 * rep) * 64 + xq_, qbc, tid); if (u >= xn_) break; if (xn_ == 32) u = u * 8 + (bid & 7); const int qb = 31 - (u >> 3), b = (u >> 2) & 1, h = u & 3;
                att::unit<0>(lds, PROJ, Y, SEL, rel_bias, forget_b[layer * 4 + h], nullptr, 0.f, nullptr, b, h, qb, tid); CVT_STEP(); }
            for (;;) { const int ch_ = q_fetch_lim(ctl + CW_CVQ, qbc, tid, CV_NCH * (layer + 1)); if (ch_ == 0x7fffffff) break; if (ch_ < CV_TOTAL) CVT_CHUNK(ch_); }
#undef CVT_STEP
        }
#endif
        xcd_barrier(bar, wid0);
        PROBE_SPIN(3);
        }
        _Pragma("unroll") for (int rep = 0; rep < NREP(4); ++rep) {
        PROBE_T0(4);
#if PHASE_ON(4)
    asm volatile("; PHASE_MARK 4");
        {
            PHASE_PTRS();
            pg8::DenseSched S; S.init((const bf16_t*)(ws + WS_Y), (const bf16_t*)(ws + WS_WOUT) + (size_t)layer * 1024 * 1024, T, 1024, G, bid);
            pg8::EpiPre E{(const bf16_t*)(ws + WS_XB), (float*)(ws + WS_PRE)};
            pg8::gemm_phase<pg8::EpiPre, pg8::DenseSched, true>(lds, S, E, tid);
        }
#endif
        xcd_barrier(bar, wid0);
        PROBE_SPIN(4);
        }
        { PROBE_T0(5);
#if PHASE_ON(5)
    asm volatile("; PHASE_MARK 5");
        {
            PHASE_PTRS();
            const float* ln1_g = IN(11); const float* ln1_b = IN(12); const float* router_b = IN(14);
            const bf16_t* RWT = (const bf16_t*)(ws + WS_RWT); const float* PRE = (const float*)(ws + WS_PRE); bf16_t* X1B = (bf16_t*)(ws + WS_X1B);
            int* TOK = (int*)(ws + WS_TOK); int* PE = (int*)(ws + WS_PE); int* PS = PE + T * 4; float* PG = (float*)(PS + T * 4);
            LAS float* red = (LAS float*)lds;
            LAS float* part = (LAS float*)(lds + 1024);
            LAS int* lcnt = (LAS int*)(lds + 1024 + 32768);
            LAS int* lbase = lcnt + 32;
            LAS int* pe_ = lbase + 32;
            LAS int* pl_ = pe_ + 128;
            LAS float* pg_ = (LAS float*)(pl_ + 128);
            const int r32 = lane & 31, hi = lane >> 5;
            const float* g1 = ln1_g + layer * 1024; const float* b1 = ln1_b + layer * 1024;
            const bf16_t* rwh = RWT + (size_t)(layer * 2 + 0) * 32 * 1024; const bf16_t* rwl = RWT + (size_t)(layer * 2 + 1) * 32 * 1024;
            unsigned* ecnt = ctl + CW_ECNT + layer * 64;
            for (int u = bid; u < T / 32; u += G) {
                const int r0 = u * 32; const int kb0 = 128 * wid + 8 * hi;
                const float* pr = PRE + (size_t)(r0 + r32) * 1024 + kb0;
                f32x4 v[8][2];
                float s = 0.f;
#pragma unroll
                for (int si = 0; si < 8; ++si) { v[si][0] = *(const f32x4*)(pr + 16 * si); v[si][1] = *(const f32x4*)(pr + 16 * si + 4);
                    s += (v[si][0][0] + v[si][0][1]) + (v[si][0][2] + v[si][0][3]) + (v[si][1][0] + v[si][1][1]) + (v[si][1][2] + v[si][1][3]); }
                s += __shfl_xor(s, 32);
                if (tid < 32) lcnt[tid] = 0;
                if (hi == 0) red[wid * 32 + r32] = s;
                __syncthreads();
                float mean = 0.f;
#pragma unroll
                for (int w = 0; w < 8; ++w) mean += red[w * 32 + r32];
                mean *= (1.0f / 1024.0f);
                float s2 = 0.f;
#pragma unroll
                for (int si = 0; si < 8; ++si)
#pragma unroll
                    for (int j = 0; j < 2; ++j) { v[si][j] = v[si][j] - mean; s2 += (v[si][j][0] * v[si][j][0] + v[si][j][1] * v[si][j][1]) + (v[si][j][2] * v[si][j][2] + v[si][j][3] * v[si][j][3]); }
                s2 += __shfl_xor(s2, 32);
                __syncthreads();
                if (hi == 0) red[wid * 32 + r32] = s2;
                __syncthreads();
                float var = 0.f;
#pragma unroll
                for (int w = 0; w < 8; ++w) var += red[w * 32 + r32];
                const float rstd = rsqrtf(var * (1.0f / 1024.0f) + LN_EPS);
                f32x16 acc = f32x16{};
                bf16_t* xbo = X1B + (size_t)(r0 + r32) * 1024 + kb0;
#pragma unroll
                for (int si = 0; si < 8; ++si) {
                    u32x4 ah, al;
#pragma unroll
                    for (int j = 0; j < 2; ++j) {
                        const f32x4 gv = *(const f32x4*)(g1 + kb0 + 16 * si + 4 * j), bv = *(const f32x4*)(b1 + kb0 + 16 * si + 4 * j);
                        const f32x4 xv = v[si][j] * rstd * gv + bv;
                        const unsigned h0 = cvtpk(xv[0], xv[1]), h1 = cvtpk(xv[2], xv[3]);
                        const unsigned l0 = cvtpk(xv[0] - __uint_as_float(h0 << 16), xv[1] - __uint_as_float(h0 & 0xffff0000u)), l1 = cvtpk(xv[2] - __uint_as_float(h1 << 16), xv[3] - __uint_as_float(h1 & 0xffff0000u));
                        ah[2 * j] = h0; ah[2 * j + 1] = h1; al[2 * j] = l0; al[2 * j + 1] = l1;
                    }
                    *(u32x4*)(xbo + 16 * si) = ah;
                    const bf16x8 bh = *(const bf16x8*)(rwh + (size_t)r32 * 1024 + kb0 + 16 * si), bl = *(const bf16x8*)(rwl + (size_t)r32 * 1024 + kb0 + 16 * si);
                    acc = __builtin_amdgcn_mfma_f32_32x32x16_bf16(__builtin_bit_cast(bf16x8, ah), bh, acc, 0, 0, 0);
                    acc = __builtin_amdgcn_mfma_f32_32x32x16_bf16(__builtin_bit_cast(bf16x8, ah), bl, acc, 0, 0, 0);
                    acc = __builtin_amdgcn_mfma_f32_32x32x16_bf16(__builtin_bit_cast(bf16x8, al), bh, acc, 0, 0, 0);
                }
#pragma unroll
                for (int r = 0; r < 16; ++r) part[(wid * 32 + att::crow(r, hi)) * 32 + r32] = acc[r];
                __syncthreads();
#pragma unroll
                for (int rnd = 0; rnd < 2; ++rnd) {
                    const int tk = 4 * wid + 2 * rnd + hi;
                    float lg_ = router_b[layer * 32 + r32];
#pragma unroll
                    for (int w = 0; w < 8; ++w) lg_ += part[(w * 32 + tk) * 32 + r32];
                    float tv[4]; int te[4];
#pragma unroll
                    for (int k = 0; k < 4; ++k) {
                        const unsigned xb_ = __float_as_uint(lg_); const unsigned key = (xb_ & 0x80000000u) ? ~xb_ : (xb_ | 0x80000000u);
                        unsigned long long kk = ((unsigned long long)key << 32) | (unsigned)(31 - r32);
#pragma unroll
                        for (int o = 1; o < 32; o <<= 1) { const unsigned long long ot = __shfl_xor(kk, o); kk = ot > kk ? ot : kk; }
                        const int ew = 31 - (int)(kk & 31u);
                        const unsigned kx = (unsigned)(kk >> 32); const unsigned vb_ = (kx & 0x80000000u) ? (kx & 0x7fffffffu) : ~kx;
                        tv[k] = __uint_as_float(vb_); te[k] = ew;
                        if (r32 == ew) lg_ = -INFINITY;
                    }
                    const float e1 = __expf(tv[1] - tv[0]), e2 = __expf(tv[2] - tv[0]), e3 = __expf(tv[3] - tv[0]);
                    const float inv = 1.0f / (1.0f + e1 + e2 + e3);
                    if (r32 < 4) {
                        const int ee = r32 == 0 ? te[0] : r32 == 1 ? te[1] : r32 == 2 ? te[2] : te[3];
                        const float gg = (r32 == 0 ? 1.0f : r32 == 1 ? e1 : r32 == 2 ? e2 : e3) * inv;
                        const int lr = __hip_atomic_fetch_add(lcnt + ee, 1, __ATOMIC_RELAXED, __HIP_MEMORY_SCOPE_WORKGROUP);
                        pe_[tk * 4 + r32] = ee; pl_[tk * 4 + r32] = lr; pg_[tk * 4 + r32] = gg;
                    }
                }
                __syncthreads();
                if (tid < 32) { const int n = lcnt[tid]; lbase[tid] = n > 0 ? (int)__hip_atomic_fetch_add(ecnt + tid, (unsigned)n, __ATOMIC_RELAXED, __HIP_MEMORY_SCOPE_AGENT) : 0; }
                __syncthreads();
                if (tid < 128) { const int ee = pe_[tid], slot = lbase[ee] + pl_[tid], tok = r0 + (tid >> 2);
                    TOK[(size_t)ee * ECAP + slot] = tok; PE[tok * 4 + (tid & 3)] = ee; PS[tok * 4 + (tid & 3)] = slot; PG[tok * 4 + (tid & 3)] = pg_[tid]; }
                __syncthreads();
            }
        }
#endif
        xcd_barrier(bar, wid0);
        PROBE_SPIN(5); }
        LAS int* t_texp = (LAS int*)(lds + LDS_TAB);
        LAS int* t_tstart = t_texp + MAXTILES;
        LAS int* t_cnt = t_tstart + 36;
        {
            PHASE_PTRS();
            unsigned* ecnt = ctl + CW_ECNT + layer * 64;
            if (tid < 64) {
                const int n = (lane < NE) ? (int)__hip_atomic_load(ecnt + (lane & 31), __ATOMIC_RELAXED, __HIP_MEMORY_SCOPE_AGENT) : 0;
                const int nt_ = (n + 255) >> 8; int incl = nt_;
#pragma unroll
                for (int off = 1; off < 64; off <<= 1) { const int yv = __shfl_up(incl, off); if (lane >= off) incl += yv; }
                const int st_ = incl - nt_;
                if (lane < NE) { t_cnt[lane] = n; t_tstart[lane] = st_;
#pragma unroll 1
                    for (int j = 0; j < nt_; ++j) t_texp[st_ + j] = lane; }
                if (lane == NE) t_tstart[NE] = st_;
            }
            __syncthreads();
        }
        const int ntiles = __builtin_amdgcn_readfirstlane(t_tstart[NE]);
        pg8::MoeTabs tabs{t_texp, t_tstart, t_cnt, ntiles};
        pg8::MoeShift shf; shf.init(ntiles, G);
        _Pragma("unroll") for (int rep = 0; rep < NREP(6); ++rep) {
        PROBE_T0(6);
#if PHASE_ON(6)
    asm volatile("; PHASE_MARK 6");
        {
            PHASE_PTRS();
            LAS int* tokl = (LAS int*)(lds + pg8::VOFF_LDS + 8192);
            { const int* TOKg = (const int*)(ws + WS_TOK);
              pg8::MoeSchedA S0{nullptr, nullptr, nullptr, nullptr, nullptr, tabs, shf, G, bid};
              for (int i = 0; ; ++i) { pg8::Unit u0; if (!S0.next(i, u0) || u0.kind) break;
                  const int pm = u0.pm, e = u0.e; const int s_ = (pm - t_tstart[e]) * 256 + (tid & 255), n = t_cnt[e];
                  if (tid < 256) tokl[i * 256 + tid] = (s_ < n) ? TOKg[(size_t)e * ECAP + s_] : 0; }
              __syncthreads(); }
            pg8::MoeSchedA S{(const bf16_t*)(ws + WS_X1B), (const bf16_t*)(ws + WS_H), (const bf16_t*)(ws + WS_WGU) + (size_t)layer * NE * 2048 * 1024, (const bf16_t*)(ws + WS_WDN) + (size_t)layer * NE * 1024 * 1024, tokl, tabs, shf, G, bid};
            pg8::EpiMoe E{pg8::EpiSwiglu{(bf16_t*)(ws + WS_H), IN(16) + (size_t)layer * NE * 2048}, pg8::EpiDown{(bf16_t*)(ws + WS_Y2), IN(18) + (size_t)layer * NE * 1024}};
            pg8::gemm_phase<pg8::EpiMoe, pg8::MoeSchedA, true>(lds, S, E, tid);
        }
#endif
        xcd_barrier(bar, wid0);
        PROBE_SPIN(6);
        }
        _Pragma("unroll") for (int rep = 0; rep < NREP(7); ++rep) {
        PROBE_T0(7);
#if PHASE_ON(7)
    asm volatile("; PHASE_MARK 7");
        {
            PHASE_PTRS();
            pg8::MoeSchedB S{(const bf16_t*)(ws + WS_H), (const bf16_t*)(ws + WS_WDN) + (size_t)layer * NE * 1024 * 1024, tabs, shf, G, bid};
            pg8::EpiDown E{(bf16_t*)(ws + WS_Y2), IN(18) + (size_t)layer * NE * 1024};
            pg8::gemm_phase<pg8::EpiDown, pg8::MoeSchedB, true>(lds, S, E, tid);
        }
#endif
        xcd_barrier(bar, wid0);
        PROBE_SPIN(7);
        }
        { PROBE_T0(8);
#if PHASE_ON(8)
    asm volatile("; PHASE_MARK 8");
        {
            PHASE_PTRS();
            const float* g2 = IN(19) + layer * 1024; const float* b2 = IN(20) + layer * 1024;
            const bf16_t* X1B = (const bf16_t*)(ws + WS_X1B); const bf16_t* Y2 = (const bf16_t*)(ws + WS_Y2); bf16_t* XB = (bf16_t*)(ws + WS_XB);
            const int* PE = (const int*)(ws + WS_PE); const int* PS = PE + T * 4; const float* PG = (const float*)(PS + T * 4);
            float* xout = (layer == DEPTH - 1) ? ap_->out : (float*)(ws + WS_XF);
            for (int rb = (bid * NWAVES + wid) * 8; rb < T; rb += G * NWAVES * 8) {
                const int pe_v = (lane < 32) ? PE[rb * 4 + lane] : 0, ps_v = (lane < 32) ? PS[rb * 4 + lane] : 0; const float pg_v = (lane < 32) ? PG[rb * 4 + lane] : 0.f;
#pragma unroll 1
                for (int i = 0; i < 8; i += 2) {
                    f32x4 v[2][4]; u32x2 yw[2][4][4]; float gk[2][4];
#pragma unroll
                    for (int r = 0; r < 2; ++r) {
                        const int row = rb + i + r;
#pragma unroll
                        for (int j = 0; j < 4; ++j) { const u32x2 xw = *(const u32x2*)(X1B + (size_t)row * 1024 + lane * 4 + 256 * j); v[r][j] = f32x4{__builtin_bit_cast(float, xw.x << 16), __builtin_bit_cast(float, xw.x & 0xffff0000u), __builtin_bit_cast(float, xw.y << 16), __builtin_bit_cast(float, xw.y & 0xffff0000u)}; }
#pragma unroll
                        for (int k = 0; k < 4; ++k) {
                            const int li = (i + r) * 4 + k;
                            const int ee = __builtin_amdgcn_readlane(pe_v, li), slot = __builtin_amdgcn_readlane(ps_v, li); gk[r][k] = __builtin_bit_cast(float, __builtin_amdgcn_readlane(__builtin_bit_cast(int, pg_v), li));
                            const bf16_t* yr = Y2 + ((size_t)__builtin_amdgcn_readfirstlane(t_tstart[ee]) * 256 + slot) * 1024 + lane * 4;
#pragma unroll
                            for (int j = 0; j < 4; ++j) yw[r][k][j] = *(const u32x2*)(yr + 256 * j);
                        }
                    }
#pragma unroll
                    for (int r = 0; r < 2; ++r) {
                        const int row = rb + i + r;
#pragma unroll
                        for (int j = 0; j < 4; ++j) v[r][j] = v[r][j] * DN_ALPHA;
#pragma unroll
                        for (int k = 0; k < 4; ++k) { const float gg = gk[r][k];
#pragma unroll
                            for (int j = 0; j < 4; ++j) { const u32x2 w = yw[r][k][j];
                                v[r][j][0] += gg * __uint_as_float(w.x << 16); v[r][j][1] += gg * __uint_as_float(w.x & 0xffff0000u); v[r][j][2] += gg * __uint_as_float(w.y << 16); v[r][j][3] += gg * __uint_as_float(w.y & 0xffff0000u); } }
                        float s_ = 0.f;
#pragma unroll
                        for (int j = 0; j < 4; ++j) s_ += (v[r][j][0] + v[r][j][1]) + (v[r][j][2] + v[r][j][3]);
                        const float mean = wave_sum(s_) * (1.0f / 1024.0f);
                        float s2 = 0.f;
#pragma unroll
                        for (int j = 0; j < 4; ++j) { v[r][j] = v[r][j] - mean; s2 += (v[r][j][0] * v[r][j][0] + v[r][j][1] * v[r][j][1]) + (v[r][j][2] * v[r][j][2] + v[r][j][3] * v[r][j][3]); }
                        const float rstd = rsqrtf(wave_sum(s2) * (1.0f / 1024.0f) + LN_EPS);
#pragma unroll
                        for (int j = 0; j < 4; ++j) {
                            const f32x4 gv = *(const f32x4*)(g2 + lane * 4 + 256 * j), bv = *(const f32x4*)(b2 + lane * 4 + 256 * j);
                            const f32x4 o = v[r][j] * rstd * gv + bv;
                            if constexpr (layer == DEPTH - 1) *(f32x4*)(xout + (size_t)row * 1024 + lane * 4 + 256 * j) = o;
                            u32x2 w; w.x = cvtpk(o[0], o[1]); w.y = cvtpk(o[2], o[3]);
                            *(u32x2*)(XB + (size_t)row * 1024 + lane * 4 + 256 * j) = w;
                        }
                    }
                }
            }
        }
#endif
        if (layer + 1 < DEPTH) xcd_barrier(bar, wid0);
        PROBE_SPIN(8); }
}

__global__ void __launch_bounds__(NTHR, 2) mega_fwd(Args args) {
    extern __shared__ __attribute__((aligned(16))) unsigned char lds_raw[];
    LAS unsigned char* lds = (LAS unsigned char*)lds_raw;
    const int G = gridDim.x, bid = blockIdx.x;
    volatile LAS unsigned* misc = (volatile LAS unsigned*)(lds + LDS_MISC);
    const int wid0 = __builtin_amdgcn_readfirstlane((int)threadIdx.x >> 6);
    if (threadIdx.x < 16) misc[threadIdx.x] = 0u;
    __syncthreads();
    XcdBarrier bar = xcd_barrier_post((unsigned*)(args.ws + WS_CTL) + CW_BAR, misc, (int)threadIdx.x);
    volatile LAS int* qbc = (volatile LAS int*)(lds + LDS_MISC + 16);

    { PROBE_T0(0);
#if PHASE_ON(0)
    asm volatile("; PHASE_MARK 0");
    {
        PHASE_PTRS();
        const float* x_in = IN(0); const float* w_in = IN(2); const float* w_out = IN(10); const float* router_w = IN(13); const float* w_gu = IN(15); const float* w_down = IN(17);
        bf16_t* WIN = (bf16_t*)(ws + WS_WIN); bf16_t* WOUT = (bf16_t*)(ws + WS_WOUT); bf16_t* RWT = (bf16_t*)(ws + WS_RWT); bf16_t* WGU = (bf16_t*)(ws + WS_WGU); bf16_t* WDN = (bf16_t*)(ws + WS_WDN); bf16_t* XB = (bf16_t*)(ws + WS_XB);
        const int gw = bid * NWAVES + wid, NGW = G * NWAVES;
        LAS unsigned char* wl = lds + wid * 9216;
        constexpr int I_IN = (PW / 64) * 16, I_OUT = 16 * 16, I_RW = 16;
        constexpr int N_IN = DEPTH * I_IN, N_OUT = DEPTH * I_OUT, N_RW = DEPTH * I_RW;
        constexpr int NITEMS = N_IN + N_OUT + N_RW;
        for (int it = gw; it < NITEMS; it += NGW) {
            int r = it;
            if (r < N_IN) { const int l = r / I_IN, q = r % I_IN, kb = q / (I_IN / 16), nb = q % (I_IN / 16); const int n = nb * 64 + lane; const int sc = win_src_col(n);
                cvt_item(w_in + (size_t)l * 1024 * NIN, NIN, sc, sc >= 0, WIN + ((size_t)l * PW + nb * 64) * 1024, kb * 64, wl, lane); continue; } r -= N_IN;
            if (r < N_OUT) { const int l = r / I_OUT, q = r % I_OUT, kb = q / (I_OUT / 16), nb = q % (I_OUT / 16); const int n = nb * 64 + lane;
                cvt_item(w_out + (size_t)l * 1024 * 1024, 1024, n, true, WOUT + ((size_t)l * 1024 + nb * 64) * 1024, kb * 64, wl, lane); continue; } r -= N_OUT;
            { const int l = r / I_RW, kb = r % I_RW;
              if (lane < 32) { const float* src = router_w + (size_t)l * 1024 * 32; bf16_t* dh = RWT + ((size_t)(l * 2 + 0) * 32 + lane) * 1024 + kb * 64; bf16_t* dl = RWT + ((size_t)(l * 2 + 1) * 32 + lane) * 1024 + kb * 64;
                  for (int j = 0; j < 64; ++j) { const float v = src[(size_t)(kb * 64 + j) * 32 + lane]; const bf16_t hb_ = f2bf(v); dh[j] = hb_; dl[j] = f2bf(v - bf2f(hb_)); } } }
        }
        for (size_t i = (size_t)bid * NTHR + tid; i < (size_t)T * D / 4; i += (size_t)G * NTHR) { const f32x4 v = *(const f32x4*)(x_in + i * 4); u32x2 w; w.x = cvtpk(v[0], v[1]); w.y = cvtpk(v[2], v[3]); *(u32x2*)(XB + i * 4) = w; }
    }
#endif
    xcd_barrier(bar, wid0);
    PROBE_SPIN(0); }

    run_layer<0>(lds, bar, qbc, G, bid, wid0);
    run_layer<1>(lds, bar, qbc, G, bid, wid0);
    run_layer<2>(lds, bar, qbc, G, bid, wid0);
    run_layer<3>(lds, bar, qbc, G, bid, wid0);
}

extern "C" void kernel_launch(void* const* d_in, const int* in_sizes, int n_in, void* d_out, int out_size, void* d_ws, size_t ws_size, hipStream_t stream) {
    static int grid = 0;
    if (grid == 0) {
        if (n_in != 21 || out_size != T * D || ws_size < WS_END) { fprintf(stderr, "kernel_launch: unexpected problem: n_in %d out %d ws %zu (need %zu)\n", n_in, out_size, ws_size, (size_t)WS_END); grid = -1; return; }
        int dev = 0, cus = 0, per_cu = 0;
        if (hipGetDevice(&dev) != hipSuccess || hipDeviceGetAttribute(&cus, hipDeviceAttributeMultiprocessorCount, dev) != hipSuccess) { fprintf(stderr, "kernel_launch: device query failed\n"); grid = -1; return; }
        if (hipFuncSetAttribute((const void*)mega_fwd, hipFuncAttributeMaxDynamicSharedMemorySize, LDS_BYTES) != hipSuccess) { fprintf(stderr, "kernel_launch: hipFuncSetAttribute failed\n"); grid = -1; return; }
        if (hipOccupancyMaxActiveBlocksPerMultiprocessor(&per_cu, (const void*)mega_fwd, NTHR, LDS_BYTES) != hipSuccess || per_cu < 1)
            fprintf(stderr, "kernel_launch: note: occupancy query reports %d workgroups per CU\n", per_cu);
        (void)hipGetLastError();
        grid = cus > 256 ? 256 : cus;
    }
    if (grid < 0) return;
    if (hipMemsetAsync((char*)d_ws + WS_CTL, 0, CTL_ZERO_BYTES, stream) != hipSuccess) { fprintf(stderr, "kernel_launch: memset failed\n"); return; }
    Args a{};
    for (int i = 0; i < 21; ++i) a.in[i] = (const float*)d_in[i];
    a.out = (float*)d_out; a.ws = (unsigned char*)d_ws;
    hipLaunchKernelGGL(mega_fwd, dim3(grid), dim3(NTHR), LDS_BYTES, stream, a);
    const hipError_t le = hipPeekAtLastError();
    if (le != hipSuccess) fprintf(stderr, "kernel_launch: launch failed: %s\n", hipGetErrorName(le));
}
```

```cpp
#include <hip/hip_runtime.h>
#include <hip/hip_bf16.h>
#include <cstdio>
#include <cstdint>
#include <cmath>

#define LAS __attribute__((address_space(3)))
typedef unsigned short bf16_t;
typedef short bf16x8 __attribute__((ext_vector_type(8)));
typedef short s16x4 __attribute__((ext_vector_type(4)));
typedef float f32x4 __attribute__((ext_vector_type(4)));
typedef float f32x2 __attribute__((ext_vector_type(2)));
typedef float f32x16 __attribute__((ext_vector_type(16)));
typedef unsigned u32x4 __attribute__((ext_vector_type(4)));
typedef unsigned u32x2 __attribute__((ext_vector_type(2)));
typedef __bf16 bf16x2_t __attribute__((ext_vector_type(2)));

constexpr int NB = 2, SEQ = 8192, T = NB * SEQ, D = 1024, DEPTH = 4;
constexpr int NIN = 3144, PW = 3328;
constexpr int C_FQ = 0, C_FK = 256, C_FV = 512, C_DQ = 768, C_DK = 1024, C_DV = 1280, C_SQ = 1536, C_SK = 1792, C_SV = 2048, C_IQ = 2304, C_IK = 2560, C_CU = 2624, C_FF = 3136, C_IW = 3140;
constexpr int NE = 32, TOPK = 4, ECAP = T;
constexpr int MAXTILES = 288;
constexpr float LN_EPS = 1e-5f;
constexpr float DN_ALPHA = 1.681792830507429f;
constexpr float LOG2E = 1.4426950408889634f;
constexpr int NWAVES = 8, NTHR = 512;

constexpr size_t MiB = 1u << 20;
constexpr size_t WS_CTL = 0, CTL_ZERO_BYTES = 1 * MiB;
constexpr size_t WS_WIN = 1 * MiB;
constexpr size_t WS_WOUT = 27 * MiB;
constexpr size_t WS_RWT = 35 * MiB;
constexpr size_t WS_WGU = 36 * MiB;
constexpr size_t WS_WDN = 548 * MiB;
constexpr size_t WS_XF = 804 * MiB;
constexpr size_t WS_XB = 868 * MiB;
constexpr size_t WS_PROJ = 900 * MiB;
constexpr size_t WS_Y = 1004 * MiB;
constexpr size_t WS_PRE = 1036 * MiB;
constexpr size_t WS_X1F = 1100 * MiB;
constexpr size_t WS_X1B = 1164 * MiB;
constexpr size_t WS_SEL = 1196 * MiB;
constexpr size_t WS_SCR = 1212 * MiB;
constexpr size_t WS_TOK = 1468 * MiB;
constexpr size_t WS_PE = 1470 * MiB;
constexpr size_t WS_H = 1472 * MiB;
constexpr size_t WS_Y2 = 1616 * MiB;
constexpr size_t WS_END = 1760 * MiB;
constexpr int CW_BAR = 0;
constexpr int CW_Q = 4096;
constexpr int CW_ECNT = 8192;

constexpr int RING_BYTES = 131072;
constexpr int LDS_TAB = RING_BYTES;
constexpr int LDS_MISC = RING_BYTES + 2048;
constexpr int LDS_BYTES = 163840;

#ifndef PROBE_MASK
#define PROBE_MASK 0
#endif
#define PROBE_T0(n) unsigned long long pt0_ = 0; if ((PROBE_MASK >> (n)) & 1) pt0_ = __builtin_amdgcn_s_memrealtime()
#define PROBE_SPIN(n) do { if ((PROBE_MASK >> (n)) & 1) { const unsigned long long t1_ = __builtin_amdgcn_s_memrealtime(); const unsigned long long d_ = t1_ - pt0_; while (__builtin_amdgcn_s_memrealtime() - t1_ < d_) __builtin_amdgcn_s_sleep(8); } } while (0)
__device__ __forceinline__ float bf2f(bf16_t v) { return __uint_as_float((unsigned)v << 16); }
__device__ __forceinline__ unsigned cvtpk(float lo, float hi) { f32x2 v = {lo, hi}; bf16x2_t b = __builtin_convertvector(v, bf16x2_t); return __builtin_bit_cast(unsigned, b); }
__device__ __forceinline__ bf16_t f2bf(float f) { return (bf16_t)(cvtpk(f, 0.f) & 0xffffu); }
__device__ __forceinline__ float wave_sum(float v) {
#pragma unroll
    for (int o = 1; o < 64; o <<= 1) v += __shfl_xor(v, o);
    return v;
}
__device__ __forceinline__ float sigmoidf_(float x) { return 1.0f / (1.0f + __expf(-x)); }
__device__ __forceinline__ int lane_id_() { int l; asm volatile("v_mbcnt_lo_u32_b32 %0, -1, 0\n\tv_mbcnt_hi_u32_b32 %0, -1, %0" : "=&v"(l)); return l; }
#define LDS_WAIT() asm volatile("s_waitcnt lgkmcnt(0)" ::: "memory")
#define VM_WAIT() asm volatile("s_waitcnt vmcnt(0)" ::: "memory")

#define XB_TMO      128
#define XB_XCNT(j)  (256  + 64 * (j))
#define XB_XSUB(j)  (1280 + 64 * (j))
#define XB_XGEN(j)  (2304 + 64 * (j))
#define XB_TOP      3328
#define XB_TOPGEN   3392
#define XCD_BAR_WORDS 3456
#define XB_SPIN_CAP (1u << 20)

__device__ __forceinline__ unsigned xb_ld(unsigned* p)              { return __hip_atomic_load(p, __ATOMIC_RELAXED, __HIP_MEMORY_SCOPE_AGENT); }
__device__ __forceinline__ unsigned xb_add(unsigned* p, unsigned v) { return __hip_atomic_fetch_add(p, v, __ATOMIC_RELAXED, __HIP_MEMORY_SCOPE_AGENT); }
__device__ __forceinline__ unsigned xb_xcc_id() { return (unsigned)__builtin_amdgcn_s_getreg((3 << 11) | 20) & 0xFu; }
#define XB_SPIN(cond, bar) do { unsigned _sp = 0; while (cond) { __builtin_amdgcn_s_sleep(1); \
    if ((++_sp & 255u) == 0u) { if (xb_ld(&(bar)[XB_TMO])) break; if (_sp > XB_SPIN_CAP) { atomicAdd(&(bar)[XB_TMO], 1u); break; } } } } while (0)

struct XcdBarrier { unsigned* bar; unsigned x; volatile LAS unsigned* st; };

__device__ __forceinline__ XcdBarrier xcd_barrier_post(unsigned* bar, volatile LAS unsigned* st, int tid) {
    XcdBarrier b; b.bar = bar; b.x = xb_xcc_id(); b.st = st;
    if (tid == 0) (void)xb_add(&bar[XB_XCNT(b.x)], 1u);
    return b;
}
__device__ __forceinline__ void xcd_barrier_complete(unsigned* bar, unsigned x, unsigned& nloc, unsigned& nx) {
    const unsigned G = gridDim.x * gridDim.y * gridDim.z;
    unsigned sum, cnt, mine, sp = 0u;
    for (;;) {
        sum = 0u; cnt = 0u; mine = 0u;
#pragma unroll
        for (unsigned j = 0; j < 16; ++j) { const unsigned c = xb_ld(&bar[XB_XCNT(j)]); sum += c; cnt += (c > 0u) ? 1u : 0u; mine = (j == x) ? c : mine; }
        if (sum == G) break;
        __builtin_amdgcn_s_sleep(1);
        if ((++sp & 255u) == 0u) { if (xb_ld(&bar[XB_TMO])) break; if (sp > XB_SPIN_CAP) { atomicAdd(&bar[XB_TMO], 1u); break; } }
    }
    nloc = mine > 0u ? mine : 1u; nx = cnt > 0u ? cnt : 1u;
}
__device__ __forceinline__ void xcd_barrier(const XcdBarrier& b, int wid0) {
    asm volatile("s_waitcnt vmcnt(0)" ::: "memory");
    __syncthreads();
    if (wid0 == 0 && lane_id_() == 0) {
        unsigned* bar = b.bar;
        __builtin_amdgcn_s_waitcnt(0);
        unsigned nloc = b.st[0], nx = b.st[1];
        if (nloc == 0u) { xcd_barrier_complete(bar, b.x, nloc, nx); b.st[0] = nloc; b.st[1] = nx; }
        const unsigned old = xb_add(&bar[XB_XSUB(b.x)], 1u);
        const unsigned gen = old / nloc;
        if (old + 1u == (gen + 1u) * nloc) {
            __builtin_amdgcn_fence(__ATOMIC_RELEASE, "agent");
            asm volatile("s_waitcnt vmcnt(0)" ::: "memory");
            const unsigned og = xb_add(&bar[XB_TOP], 1u);
            const unsigned tg = og / nx;
            if (og + 1u == (tg + 1u) * nx) xb_add(&bar[XB_TOPGEN], 1u);
            else XB_SPIN(xb_ld(&bar[XB_TOPGEN]) == tg, bar);
            __builtin_amdgcn_fence(__ATOMIC_ACQUIRE, "agent");
            xb_add(&bar[XB_XGEN(b.x)], 1u);
            asm volatile("s_waitcnt vmcnt(0)" ::: "memory");
        } else {
            XB_SPIN(xb_ld(&bar[XB_XGEN(b.x)]) == gen, bar);
            __builtin_amdgcn_fence(__ATOMIC_ACQUIRE, "agent");
            asm volatile("s_waitcnt vmcnt(0)" ::: "memory");
        }
    }
    __syncthreads();
}

namespace pg8 {
constexpr int BM = 256, BK = 64, HALF = 128, HTB = HALF * BK * 2, STAGE_BYTES = 8 * HTB, KD = 1024, VOFF_LDS = STAGE_BYTES + 4096, BIAS_LDS = 153600;
__host__ __device__ __forceinline__ int lds_byte(int r, int c) { const int st = (r >> 4) * 2 + (c >> 5), rr = r & 15, cc = c & 31, ob = rr * 64 + cc * 2; return st * 1024 + (ob ^ (((ob >> 9) & 1) << 5)); }
__host__ __device__ __forceinline__ void stage_rc(int b, int& R, int& C) { const int st = b / 1024, sb = b % 1024, swz = sb ^ (((sb >> 9) & 1) << 5); R = (st >> 1) * 16 + swz / 64; C = (st & 1) * 32 + (swz % 64) / 2; }
__host__ __device__ __forceinline__ int perm32(int rho) { const int n = rho >> 4, i = rho & 15; return 8 * (i >> 2) + 4 * n + (i & 3); }

struct Unit { int pm, pn, e, ord, kind; };

template <class Epi, class Sched, bool ALIGN_EPI>
__device__ __forceinline__ void gemm_phase(LAS unsigned char* lds, const Sched& S, const Epi& E, const int tid) {
    const int wid = __builtin_amdgcn_readfirstlane(tid >> 6), lane = tid & 63, wr = wid >> 2, wc = wid & 3, fr = lane & 15, fq = lane >> 4;
    constexpr int K = KD, nt = K / BK;
    int Rr[2], Cc[2]; unsigned voffB[2];
#pragma unroll
    for (int i = 0; i < 2; ++i) { int R, C; stage_rc(tid * 16 + i * 8192, R, C); const int Rb = Epi::PERM ? ((R & ~31) + perm32(R & 31)) : R; Rr[i] = R; Cc[i] = C; voffB[i] = (unsigned)(Rb * K + C) * 2u; }
    constexpr size_t kstep = (size_t)(BK * 2);
    constexpr size_t hstep = (size_t)HALF * K * 2;
    const unsigned ldsw = (unsigned)wid * 1024u;
    const int aoff = lds_byte(wr * 64 + fr, fq * 8), boff = lds_byte(wc * 32 + fr, fq * 8);
#define PG8_SA(b, h) (((b) * 2 + (h)) * HTB)
#define PG8_SB(b, h) ((4 + (b) * 2 + (h)) * HTB)
#define PG8_STAGE(bufoff, gbase, voff) do { _Pragma("unroll") for (int _i = 0; _i < 2; ++_i) \
        __builtin_amdgcn_global_load_lds((const unsigned*)((const char*)(gbase) + (voff)[_i]), (LAS unsigned*)(lds + (bufoff) + ldsw + _i * 8192), 16, 0, 0); } while (0)
#define PG8_LDA(dst, b, h) do { _Pragma("unroll") for (int m = 0; m < 4; ++m) _Pragma("unroll") for (int k = 0; k < 2; ++k) dst[m][k] = *(const LAS bf16x8*)(lds + PG8_SA(b, h) + aoff + m * 2048 + k * 1024); } while (0)
#define PG8_LDB(dst, b, h) do { _Pragma("unroll") for (int n = 0; n < 2; ++n) _Pragma("unroll") for (int k = 0; k < 2; ++k) dst[n][k] = *(const LAS bf16x8*)(lds + PG8_SB(b, h) + boff + n * 2048 + k * 1024); } while (0)
#define PG8_MMA(ai, bj, At, Bt) do { __builtin_amdgcn_s_setprio(1); _Pragma("unroll") for (int m = 0; m < 4; ++m) _Pragma("unroll") for (int n = 0; n < 2; ++n) _Pragma("unroll") for (int k = 0; k < 2; ++k) \
        acc[ai][bj][m][n] = __builtin_amdgcn_mfma_f32_16x16x32_bf16(Bt[n][k], At[m][k], acc[ai][bj][m][n], 0, 0, 0); __builtin_amdgcn_s_setprio(0); } while (0)
#define PG8_WAIT_V(n) asm volatile("s_waitcnt vmcnt(" #n ")" ::: "memory")
#define PG8_WAIT_L(n) asm volatile("s_waitcnt lgkmcnt(" #n ")" ::: "memory")
#define PG8_BAR __builtin_amdgcn_s_barrier()
#define PG8_SCHED __builtin_amdgcn_sched_barrier(0)
    Unit cur, nxt; int ui = 0;
    if (!S.next(0, cur)) return;
    f32x4 acc[2][2][4][2];
#pragma unroll
    for (int a = 0; a < 2; ++a)
#pragma unroll
        for (int b = 0; b < 2; ++b)
#pragma unroll
            for (int m = 0; m < 4; ++m)
#pragma unroll
                for (int n = 0; n < 2; ++n) acc[a][b][m][n] = (f32x4){0.f, 0.f, 0.f, 0.f};
    bf16x8 At[4][2], B0[2][2], B1[2][2];
    constexpr bool GA = Sched::GATHER;
    unsigned vAc[2][2], vAn[2][2];
    if constexpr (GA) S.a_voff(cur, tid, vAc);
    else {
#pragma unroll
        for (int i = 0; i < 2; ++i) { vAc[0][i] = (unsigned)(Rr[i] * K + Cc[i]) * 2u; vAc[1][i] = vAc[0][i]; vAn[0][i] = vAc[0][i]; vAn[1][i] = vAc[0][i]; }
    }
    constexpr size_t ah = GA ? (size_t)0 : hstep;
    const char* cA = S.a_base(cur); const char* cB = S.b_base(cur);
    PG8_STAGE(PG8_SB(0, 0), cB, voffB); PG8_STAGE(PG8_SB(0, 1), cB + hstep, voffB); PG8_STAGE(PG8_SA(0, 0), cA, vAc[0]); PG8_STAGE(PG8_SA(0, 1), cA + ah, vAc[1]);
    if (wr == 1) PG8_BAR;
    PG8_WAIT_V(2); PG8_BAR;
    PG8_STAGE(PG8_SB(1, 0), cB + kstep, voffB); PG8_STAGE(PG8_SA(1, 0), cA + kstep, vAc[0]); PG8_STAGE(PG8_SB(1, 1), cB + hstep + kstep, voffB);
    PG8_WAIT_V(6); PG8_BAR;
    for (;;) {
        const bool has_next = S.next(ui + 1, nxt);
        if constexpr (Epi::LDS_BIAS) { if (wid == 0) __builtin_amdgcn_global_load_lds((const unsigned*)(E.bias_src(cur) + lane * 4), (LAS unsigned*)(lds + BIAS_LDS + (ui & 1) * 1024), 16, 0, 0); }
        const char* nA = has_next ? S.a_base(nxt) : cA; const char* nB = has_next ? S.b_base(nxt) : cB;
        if constexpr (GA) {
            if (has_next) S.a_voff(nxt, tid, vAn);
            else { vAn[0][0] = vAc[0][0]; vAn[0][1] = vAc[0][1]; vAn[1][0] = vAc[1][0]; vAn[1][1] = vAc[1][1]; }
            *(LAS u32x4*)(lds + VOFF_LDS + tid * 16) = (u32x4){vAn[0][0], vAn[0][1], vAn[1][0], vAn[1][1]};
        }
        for (int t = 0; t < nt; t += 2) {
            const bool last = (t == nt - 2);
            const char* a1 = cA + (size_t)(t + 1) * kstep;
            const char* a2 = last ? nA : cA + (size_t)(t + 2) * kstep; const char* b2 = last ? nB : cB + (size_t)(t + 2) * kstep;
            const char* a3 = a2 + kstep; const char* b3 = b2 + kstep;
            PG8_LDB(B0, 0, 0); PG8_LDB(B1, 0, 1); PG8_SCHED; PG8_LDA(At, 0, 0); PG8_STAGE(PG8_SA(1, 1), a1 + ah, vAc[1]);
            if constexpr (GA) { if (last) { const u32x4 nv = *(const LAS u32x4*)(lds + VOFF_LDS + tid * 16); vAc[0][0] = nv[0]; vAc[0][1] = nv[1]; vAc[1][0] = nv[2]; vAc[1][1] = nv[3]; } }
            PG8_WAIT_V(8); PG8_WAIT_L(0); PG8_BAR; PG8_MMA(0, 0, At, B0); PG8_MMA(0, 1, At, B1); PG8_BAR; PG8_SCHED;
            PG8_LDA(At, 0, 1); PG8_STAGE(PG8_SB(0, 0), b2, voffB); PG8_STAGE(PG8_SB(0, 1), b2 + hstep, voffB); PG8_STAGE(PG8_SA(0, 0), a2, vAc[0]);
            PG8_WAIT_V(8); PG8_WAIT_L(0); PG8_BAR; PG8_MMA(1, 0, At, B0); PG8_MMA(1, 1, At, B1); PG8_BAR; PG8_SCHED;
            PG8_LDB(B0, 1, 0); PG8_LDB(B1, 1, 1); PG8_SCHED; PG8_LDA(At, 1, 0); PG8_STAGE(PG8_SA(0, 1), a2 + ah, vAc[1]);
            PG8_WAIT_V(8); PG8_WAIT_L(0); PG8_BAR; PG8_MMA(0, 0, At, B0); PG8_MMA(0, 1, At, B1); PG8_BAR; PG8_SCHED;
            PG8_LDA(At, 1, 1); PG8_STAGE(PG8_SB(1, 0), b3, voffB); PG8_STAGE(PG8_SB(1, 1), b3 + hstep, voffB); PG8_STAGE(PG8_SA(1, 0), a3, vAc[0]);
            PG8_WAIT_V(8); PG8_WAIT_L(0); PG8_BAR; PG8_MMA(1, 0, At, B0); PG8_MMA(1, 1, At, B1); PG8_BAR; PG8_SCHED;
        }
        if constexpr (ALIGN_EPI) { if (wr == 0) PG8_BAR; }
        { int te = tid; asm volatile("" : "+v"(te)); const int lw = __builtin_amdgcn_readfirstlane(te >> 6); E(acc, cur, lw >> 2, lw & 3, te & 15, (te & 63) >> 4, (const LAS float*)(lds + BIAS_LDS + (ui & 1) * 1024)); }
        if (!has_next) break;
#pragma unroll
        for (int a = 0; a < 2; ++a)
#pragma unroll
            for (int b = 0; b < 2; ++b)
#pragma unroll
                for (int m = 0; m < 4; ++m)
#pragma unroll
                    for (int n = 0; n < 2; ++n) acc[a][b][m][n] = (f32x4){0.f, 0.f, 0.f, 0.f};
        cur = nxt; cA = nA; cB = nB; ++ui;
        if constexpr (ALIGN_EPI) { if (wr == 1) PG8_BAR; }
    }
    PG8_WAIT_V(0);
    if constexpr (!ALIGN_EPI) { if (wr == 0) PG8_BAR; }
    PG8_BAR;
#undef PG8_SA
#undef PG8_SB
#undef PG8_STAGE
#undef PG8_LDA
#undef PG8_LDB
#undef PG8_MMA
#undef PG8_WAIT_V
#undef PG8_WAIT_L
#undef PG8_BAR
#undef PG8_SCHED
}

struct DenseSched {
    const bf16_t* A; const bf16_t* Bt; int nM, nN, nwg, G, c;
    __device__ __forceinline__ void init(const bf16_t* A_, const bf16_t* Bt_, int M, int N, int G_, int c_) { A = A_; Bt = Bt_; nM = M / BM; nN = N / BM; nwg = nM * nN; G = G_; c = c_; }
    __device__ __forceinline__ bool next(int i, Unit& u) const {
        const long L = (long)i * G + c; if (L >= nwg) return false;
        int wgid = (int)L; { const int q = nwg / 8, r = nwg % 8, xcd = wgid % 8, off = wgid / 8; wgid = (xcd < r ? xcd * (q + 1) : r * (q + 1) + (xcd - r) * q) + off; }
        const int nig = 8 * nN, gid = wgid / nig, fm = gid * 8, gsz = (nM - fm) < 8 ? (nM - fm) : 8;
        u.pm = fm + ((wgid % nig) % gsz); u.pn = (wgid % nig) / gsz; u.e = 0; u.ord = i; u.kind = 0; return true;
    }
    static constexpr bool GATHER = false;
    __device__ __forceinline__ const char* a_base(const Unit& u) const { return (const char*)A + (size_t)u.pm * BM * KD * 2; }
    __device__ __forceinline__ const char* b_base(const Unit& u) const { return (const char*)Bt + (size_t)u.pn * BM * KD * 2; }
};
struct MoeTabs { const LAS int* texp; const LAS int* tstart; const LAS int* cnt; int ntiles; };
struct MoeShift { int on, nOwn, nSh, ntS;
    __device__ __forceinline__ void init(int ntiles, int G) { on = (G == 256 && ntiles > 256 && ntiles < 288) ? 1 : 0; nOwn = on ? 8 * (288 - ntiles) : 0; nSh = 256 - nOwn; ntS = on ? nSh * 9 / 8 : ntiles; } };
struct MoeSchedA {
    const bf16_t* X1B; const bf16_t* Hm; const bf16_t* Wgu; const bf16_t* Wdn; const LAS int* tokl; MoeTabs tb; MoeShift sh; int G, c;
    __device__ __forceinline__ bool next(int i, Unit& u) const {
        if (!sh.on) { const long L = (long)i * G + c; if (L >= (long)tb.ntiles * 8) return false; u.pm = (int)(L >> 3); u.pn = (int)(L & 7); u.kind = 0; }
        else { if (i >= 9) return false;
            if (c < sh.nSh) { const int L = (c & 7) * sh.ntS + i * (sh.nSh >> 3) + (c >> 3); u.pm = L >> 3; u.pn = L & 7; u.kind = 0; }
            else { const int j = c - sh.nSh; u.pm = sh.ntS + (j & 7) * (sh.nOwn >> 3) + (j >> 3); u.pn = i & 7; u.kind = i >> 3; } }
        u.e = __builtin_amdgcn_readfirstlane(tb.texp[u.pm]); u.ord = i; return true;
    }
    static constexpr bool GATHER = true;
    __device__ __forceinline__ const char* a_base(const Unit& u) const { return u.kind ? (const char*)Hm : (const char*)X1B; }
    __device__ __forceinline__ const char* b_base(const Unit& u) const { return u.kind ? (const char*)Wdn + ((size_t)u.e * 4 + u.pn) * BM * KD * 2 : (const char*)Wgu + ((size_t)u.e * 8 + u.pn) * BM * KD * 2; }
    __device__ __forceinline__ void a_voff(const Unit& u, int tid, unsigned (&v)[2][2]) const {
#pragma unroll
        for (int i = 0; i < 2; ++i) { int R, C; stage_rc(tid * 16 + i * 8192, R, C);
#pragma unroll
            for (int h = 0; h < 2; ++h) { int tk; if (u.kind) tk = u.pm * BM + h * HALF + R; else tk = tokl[u.ord * BM + h * HALF + R]; v[h][i] = (unsigned)(tk * KD + C) * 2u; } }
    }
};
struct MoeSchedB {
    const bf16_t* A; const bf16_t* Bt; MoeTabs tb; MoeShift sh; int G, c;
    __device__ __forceinline__ bool next(int i, Unit& u) const {
        const int ntot = tb.ntiles * 4 - sh.nOwn; int L;
        if (G == 256) {
            const int q = ntot >> 3, rem = ntot & 7, x = c & 7, j = c >> 3, size = q + (x < rem ? 1 : 0), start = x * q + (x < rem ? x : rem), m = i * 32 + j;
            if (m >= size) return false; L = start + m; }
        else { L = i * G + c; if (L >= ntot) return false; }
        if (L < sh.ntS * 4) { u.pm = L >> 2; u.pn = L & 3; } else { const int L2 = L - sh.ntS * 4, q = L2 / 3; u.pm = sh.ntS + q; u.pn = 1 + (L2 - 3 * q); }
        u.e = __builtin_amdgcn_readfirstlane(tb.texp[u.pm]); u.ord = i; u.kind = 1; return true;
    }
    static constexpr bool GATHER = false;
    __device__ __forceinline__ const char* a_base(const Unit& u) const { return (const char*)A + (size_t)u.pm * BM * KD * 2; }
    __device__ __forceinline__ const char* b_base(const Unit& u) const { return (const char*)Bt + ((size_t)u.e * 4 + u.pn) * BM * KD * 2; }
};

struct EpiProj {
    static constexpr bool PERM = true, LDS_BIAS = false;
    bf16_t* O;
    __device__ __forceinline__ void operator()(const f32x4 (&acc)[2][2][4][2], const Unit& u, int wr, int wc, int fr, int fq, const LAS float* bl) const {
        const int row0 = u.pm * BM + wr * 64 + fr, col0 = u.pn * BM + wc * 32 + 8 * fq;
#pragma unroll
        for (int ai = 0; ai < 2; ++ai)
#pragma unroll
            for (int m = 0; m < 4; ++m) { bf16_t* rowp = O + (size_t)(row0 + ai * HALF + m * 16) * PW + col0;
#pragma unroll
                for (int bj = 0; bj < 2; ++bj) { const f32x4 v0 = acc[ai][bj][m][0], v1 = acc[ai][bj][m][1];
                    u32x4 w; w.x = cvtpk(v0[0], v0[1]); w.y = cvtpk(v0[2], v0[3]); w.z = cvtpk(v1[0], v1[1]); w.w = cvtpk(v1[2], v1[3]);
                    *(u32x4*)(rowp + bj * HALF) = w; } }
    }
};
struct EpiPre {
    static constexpr bool PERM = false, LDS_BIAS = false;
    const bf16_t* X; float* O;
    __device__ __forceinline__ void operator()(const f32x4 (&acc)[2][2][4][2], const Unit& u, int wr, int wc, int fr, int fq, const LAS float* bl) const {
        const int row0 = u.pm * BM + wr * 64 + fr, col0 = u.pn * BM + wc * 32 + 4 * fq;
#pragma unroll
        for (int ai = 0; ai < 2; ++ai)
#pragma unroll
            for (int m = 0; m < 4; ++m) { const size_t off = (size_t)(row0 + ai * HALF + m * 16) * D + col0;
#pragma unroll
                for (int bj = 0; bj < 2; ++bj)
#pragma unroll
                    for (int n = 0; n < 2; ++n) { const u32x2 xw = *(const u32x2*)(X + off + bj * HALF + n * 16); const f32x4 xv = {__builtin_bit_cast(float, xw.x << 16), __builtin_bit_cast(float, xw.x & 0xffff0000u), __builtin_bit_cast(float, xw.y << 16), __builtin_bit_cast(float, xw.y & 0xffff0000u)};
                        *(f32x4*)(O + off + bj * HALF + n * 16) = xv * DN_ALPHA + acc[ai][bj][m][n]; } }
    }
};
struct EpiSwiglu {
    static constexpr bool PERM = true, LDS_BIAS = true;
    bf16_t* H; const float* bgu;
    __device__ __forceinline__ const float* bias_src(const Unit& u) const { return bgu + (size_t)u.e * 2048 + u.pn * BM; }
    __device__ __forceinline__ void operator()(const f32x4 (&acc)[2][2][4][2], const Unit& u, int wr, int wc, int fr, int fq, const LAS float* bl) const {
        const int row0 = u.pm * BM + wr * 64 + fr, col0 = u.pn * BM + wc * 32 + 8 * fq;
        const LAS float* bp = bl + wc * 32 + 8 * fq;
        f32x4 bv[2][2];
#pragma unroll
        for (int bj = 0; bj < 2; ++bj)
#pragma unroll
            for (int n = 0; n < 2; ++n) bv[bj][n] = *(const LAS f32x4*)(bp + bj * HALF + 4 * n);
#pragma unroll
        for (int ai = 0; ai < 2; ++ai)
#pragma unroll
            for (int m = 0; m < 4; ++m) { bf16_t* rowp = H + (size_t)(row0 + ai * HALF + m * 16) * 1024 + (col0 >> 1);
#pragma unroll
                for (int bj = 0; bj < 2; ++bj) { const f32x4 v0 = acc[ai][bj][m][0] + bv[bj][0], v1 = acc[ai][bj][m][1] + bv[bj][1];
                    float hv[4];
#pragma unroll
                    for (int j = 0; j < 4; ++j) { const float g_ = j < 2 ? v0[2 * j] : v1[2 * j - 4], u_ = j < 2 ? v0[2 * j + 1] : v1[2 * j - 3];
                        const float gate = fminf(g_, 7.0f), up = fminf(fmaxf(u_, -7.0f), 7.0f);
                        hv[j] = (up + 1.0f) * gate * __builtin_amdgcn_rcpf(1.0f + __builtin_amdgcn_exp2f(-1.702f * LOG2E * gate)); }
                    u32x2 w; w.x = cvtpk(hv[0], hv[1]); w.y = cvtpk(hv[2], hv[3]);
                    *(u32x2*)(rowp + bj * (HALF / 2)) = w; } }
    }
};
struct EpiDown {
    static constexpr bool PERM = true, LDS_BIAS = true;
    bf16_t* O; const float* bd;
    __device__ __forceinline__ const float* bias_src(const Unit& u) const { return bd + (size_t)u.e * 1024 + u.pn * BM; }
    __device__ __forceinline__ void operator()(const f32x4 (&acc)[2][2][4][2], const Unit& u, int wr, int wc, int fr, int fq, const LAS float* bl) const {
        const int row0 = u.pm * BM + wr * 64 + fr, col0 = u.pn * BM + wc * 32 + 8 * fq;
        const LAS float* bp = bl + wc * 32 + 8 * fq;
        f32x4 bv[2][2];
#pragma unroll
        for (int bj = 0; bj < 2; ++bj)
#pragma unroll
            for (int n = 0; n < 2; ++n) bv[bj][n] = *(const LAS f32x4*)(bp + bj * HALF + 4 * n);
#pragma unroll
        for (int ai = 0; ai < 2; ++ai)
#pragma unroll
            for (int m = 0; m < 4; ++m) { bf16_t* rowp = O + (size_t)(row0 + ai * HALF + m * 16) * 1024 + col0;
#pragma unroll
                for (int bj = 0; bj < 2; ++bj) { const f32x4 v0 = acc[ai][bj][m][0] + bv[bj][0], v1 = acc[ai][bj][m][1] + bv[bj][1];
                    u32x4 w; w.x = cvtpk(v0[0], v0[1]); w.y = cvtpk(v0[2], v0[3]); w.z = cvtpk(v1[0], v1[1]); w.w = cvtpk(v1[2], v1[3]);
                    *(u32x4*)(rowp + bj * HALF) = w; } }
    }
};
struct EpiMoe {
    static constexpr bool PERM = true, LDS_BIAS = true;
    EpiSwiglu es; EpiDown ed;
    __device__ __forceinline__ const float* bias_src(const Unit& u) const { return u.kind ? ed.bias_src(u) : es.bias_src(u); }
    __device__ __forceinline__ void operator()(const f32x4 (&acc)[2][2][4][2], const Unit& u, int wr, int wc, int fr, int fq, const LAS float* bl) const {
        if (u.kind == 0) es(acc, u, wr, wc, fr, fq, bl); else ed(acc, u, wr, wc, fr, fq, bl);
    }
};
}

__device__ __forceinline__ void glds16(const void* gsrc, unsigned lds_dst) { unsigned keep;
    asm volatile("s_mov_b32 %0, m0\n\ts_mov_b32 m0, %2\n\ts_nop 0\n\tglobal_load_lds_dwordx4 %1, off\n\ts_mov_b32 m0, %0" : "=&s"(keep) : "v"(gsrc), "s"(lds_dst) : "memory"); }
namespace att {
constexpr int NSLOT = 6, L_K = 0, L_V = 49152, L_CL = 98304, L_Q = 98304, L_TB = 131072, L_WT = 131584;
typedef short v4i16_t __attribute__((ext_vector_type(4)));
__device__ __forceinline__ s16x4 vtr(const LAS unsigned char* p) { return __builtin_bit_cast(s16x4, __builtin_amdgcn_ds_read_tr16_b64_v4i16((LAS v4i16_t*)p)); }
__device__ __forceinline__ int t5_bucket(int d) {
    if (d < 16) return d;
    int b = 16;
    b += (d >= 19); b += (d >= 21); b += (d >= 24); b += (d >= 27); b += (d >= 31); b += (d >= 35); b += (d >= 40); b += (d >= 46);
    b += (d >= 52); b += (d >= 59); b += (d >= 67); b += (d >= 77); b += (d >= 87); b += (d >= 99); b += (d >= 113);
    return b;
}
__device__ __forceinline__ int crow(int r, int hi) { return (r & 3) + 8 * (r >> 2) + 4 * hi; }

constexpr float ATT_THR = 8.0f;
__device__ __forceinline__ void softmax2(f32x16& s0, f32x16& s1, float& m, float& l, f32x16 (&o)[2], u32x4 (&pk)[4]) {
    float a = fmaxf(fmaxf(s0[0], s0[1]), s1[0]), c = fmaxf(fmaxf(s0[2], s0[3]), s1[1]);
    a = fmaxf(fmaxf(a, s1[2]), s1[3]);
#pragma unroll
    for (int r = 4; r < 16; r += 4) { a = fmaxf(fmaxf(a, s0[r]), s0[r + 1]); c = fmaxf(fmaxf(c, s0[r + 2]), s0[r + 3]); a = fmaxf(fmaxf(a, s1[r]), s1[r + 1]); c = fmaxf(fmaxf(c, s1[r + 2]), s1[r + 3]); }
    float rm = fmaxf(a, c);
    rm = fmaxf(rm, __shfl_xor(rm, 32));
    if (__any(rm > ATT_THR)) {
        const float d = fmaxf(rm, 0.f);
        m += d;
        const float f = __builtin_amdgcn_exp2f(-d);
        l *= f;
#pragma unroll
        for (int r = 0; r < 16; ++r) { s0[r] -= d; s1[r] -= d; o[0][r] *= f; o[1][r] *= f; }
    }
    float rs = 0.f;
#pragma unroll
    for (int r = 0; r < 16; ++r) { s0[r] = __builtin_amdgcn_exp2f(s0[r]); rs += s0[r]; }
#pragma unroll
    for (int r = 0; r < 16; ++r) { s1[r] = __builtin_amdgcn_exp2f(s1[r]); rs += s1[r]; }
    l += rs;
#pragma unroll
    for (int i = 0; i < 4; ++i) { pk[0][i] = cvtpk(s0[2 * i], s0[2 * i + 1]); pk[1][i] = cvtpk(s0[8 + 2 * i], s0[8 + 2 * i + 1]); pk[2][i] = cvtpk(s1[2 * i], s1[2 * i + 1]); pk[3][i] = cvtpk(s1[8 + 2 * i], s1[8 + 2 * i + 1]); }
}

template <int TYPE, bool BAND>
__device__ __forceinline__ void bias_mask2(f32x16& s0, f32x16& s1, const LAS float* cl, const LAS float* tbn, int kt, int qg, int qw0, int hi, unsigned long long mw) {
    const int kbase = kt * 64 + 4 * hi;
    int dbase = qg - kbase; asm volatile("" : "+v"(dbase));
    if constexpr (TYPE == 0) {
#pragma unroll
        for (int g = 0; g < 4; ++g) { const f32x4 c0 = *(const LAS f32x4*)(cl + kbase + 8 * g), c1 = *(const LAS f32x4*)(cl + kbase + 32 + 8 * g);
#pragma unroll
            for (int j = 0; j < 4; ++j) { s0[4 * g + j] -= c0[j]; s1[4 * g + j] -= c1[j]; } }
        if constexpr (BAND) {
#pragma unroll
            for (int r = 0; r < 16; ++r) { const int c = (r & 3) + 8 * (r >> 2); if (c > dbase) s0[r] = -INFINITY; if (c + 32 > dbase) s1[r] = -INFINITY; }
        }
    } else {
        const bool far = (kt * 64 + 63 + 113 <= qw0);
        if (!far) {
#pragma unroll
            for (int r = 0; r < 16; ++r) {
                const int d0 = dbase - ((r & 3) + 8 * (r >> 2)), d1 = d0 - 32;
                const float b0 = tbn[min(max(d0, 0), 127)], b1 = tbn[min(max(d1, 0), 127)];
                s0[r] = (d0 < 0) ? -INFINITY : s0[r] + b0; s1[r] = (d1 < 0) ? -INFINITY : s1[r] + b1;
                if ((r & 3) == 3) __builtin_amdgcn_sched_barrier(0);
            }
        }
        if constexpr (TYPE == 2) {
            const unsigned mlo = (unsigned)mw >> (4 * hi), mhi = (unsigned)(mw >> 32) >> (4 * hi);
#pragma unroll
            for (int r = 0; r < 16; ++r) { const int c = (r & 3) + 8 * (r >> 2); if (!((mlo >> c) & 1u)) s0[r] = -INFINITY; if (!((mhi >> c) & 1u)) s1[r] = -INFINITY; }
        }
    }
}
template <bool FENCE = true>
__device__ __forceinline__ void pv_step(f32x16 (&o)[2], const u32x4 (&pk)[4], const LAS unsigned char* vb) {
#pragma unroll
    for (int db = 0; db < 2; ++db) {
#pragma unroll
        for (int s = 0; s < 4; ++s) {
            const s16x4 lo = vtr(vb + db * 4096 + s * 1024), hh = vtr(vb + db * 4096 + s * 1024 + 512);
            const bf16x8 vf = (bf16x8){lo[0], lo[1], lo[2], lo[3], hh[0], hh[1], hh[2], hh[3]};
            o[db] = __builtin_amdgcn_mfma_f32_32x32x16_bf16(vf, __builtin_bit_cast(bf16x8, pk[s]), o[db], 0, 0, 0);
        }
        if (FENCE) __builtin_amdgcn_sched_barrier(0);
    }
}

template <int TYPE>
__device__ __forceinline__ void unit(LAS unsigned char* lds, const bf16_t* __restrict__ proj, bf16_t* __restrict__ y, const unsigned long long* __restrict__ sel,
                                     const float* __restrict__ relb, float fbias, const float* __restrict__ dlam, float lam_init, const float* __restrict__ dng, int b, int h, int qb, const int tid) {
    const int lane = tid & 63, r32 = lane & 31, hi = lane >> 5;
    const int wid = __builtin_amdgcn_readfirstlane(tid >> 6);
    constexpr int QOFF = TYPE == 0 ? C_FQ : TYPE == 1 ? C_DQ : C_SQ, KOFF = TYPE == 0 ? C_FK : TYPE == 1 ? C_DK : C_SK, VOFF = TYPE == 0 ? C_FV : TYPE == 1 ? C_DV : C_SV;
    constexpr float SCL = (TYPE == 1 ? 0.17677669529663687f : 0.125f) * LOG2E;
    const size_t rowbase = (size_t)b * SEQ; const int q0 = qb * 256; const int qw0 = q0 + 32 * wid; const int qg = qw0 + r32;
    const int NT = (qb + 1) * 4;
    LAS float* cl = (LAS float*)(lds + L_CL); LAS float* tb = (LAS float*)(lds + L_TB); LAS float* wt = (LAS float*)(lds + L_WT);
    const bf16_t* kg; const bf16_t* vg;
    { const int row = 8 * wid + (lane >> 3), c = (lane & 7) ^ ((row >> 1) & 7); kg = proj + (rowbase + row) * PW + KOFF + h * 64 + c * 8; }
    { const int row = 16 * (wid & 3) + (lane >> 2), c = (wid >> 2) * 4 + (lane & 3); vg = proj + (rowbase + row) * PW + VOFF + h * 64 + c * 8; }
    const unsigned lds0 = (unsigned)(__UINTPTR_TYPE__)lds;
#define ATT_DMA(kt_, slot_) do { const int t_ = min((kt_), NT - 1); const unsigned so_ = (unsigned)((slot_) * 8192 + wid * 1024); \
        glds16(kg + (size_t)t_ * 64 * PW, (unsigned)__builtin_amdgcn_readfirstlane((int)(lds0 + L_K + so_))); glds16(vg + (size_t)t_ * 64 * PW, (unsigned)__builtin_amdgcn_readfirstlane((int)(lds0 + L_V + so_))); } while (0)
#define ATT_WRAP(x) ((x) >= NSLOT ? (x) - NSLOT : (x))
#define ATT_WAITBAR(N) asm volatile("s_waitcnt vmcnt(" #N ") lgkmcnt(0)\n\ts_barrier" ::: "memory")
#define ATT_MWLOAD(dst, idx_) asm volatile("global_load_dwordx2 %0, %1, off" : "=v"(dst) : "v"(selp + (size_t)min((idx_), NT - 1) * SEQ) : "memory")
    const unsigned long long* selp = sel + (size_t)b * 128 * SEQ + qg;
    unsigned long long mwE = 0ull, mwO = 0ull;
    if constexpr (TYPE == 2) { ATT_MWLOAD(mwE, 0); ATT_MWLOAD(mwO, 1); }
    ATT_DMA(0, 0); ATT_DMA(1, 1); ATT_DMA(2, 2); if constexpr (TYPE != 1) ATT_DMA(3, 3);
    bf16x8 qf[4];
    { const bf16_t* qp = proj + (rowbase + qg) * PW + QOFF + h * 64 + 8 * hi;
#pragma unroll
      for (int s = 0; s < 4; ++s) { const u32x4 raw = *(const u32x4*)(qp + 16 * s); u32x4 sc;
#pragma unroll
          for (int i = 0; i < 4; ++i) sc[i] = cvtpk(__uint_as_float(raw[i] << 16) * SCL, __uint_as_float(raw[i] & 0xffff0000u) * SCL);
          qf[s] = __builtin_bit_cast(bf16x8, sc); if constexpr (TYPE == 1) *(LAS bf16x8*)(lds + L_Q + wid * 4096 + s * 1024 + lane * 16) = qf[s]; } }
    float lam = 0.f;
    if constexpr (TYPE == 0) {
        const int n = (qb + 1) * 256;
        float v[16]; float run = 0.f;
        const bf16_t* fp = proj + (rowbase + (size_t)tid * 16) * PW + C_FF + h;
#pragma unroll
        for (int i = 0; i < 16; ++i) {
            float ls = 0.f;
            if (tid * 16 + i < n) { const float x = bf2f(fp[(size_t)i * PW]) + fbias; ls = (x >= 0.f) ? -log1pf(__expf(-x)) : (x - log1pf(__expf(x))); }
            run += ls; v[i] = run;
        }
        float incl = run;
#pragma unroll
        for (int off = 1; off < 64; off <<= 1) { const float yv = __shfl_up(incl, off); if (lane >= off) incl += yv; }
        if (lane == 63) wt[wid] = incl;
        __syncthreads();
        float woff = 0.f;
        for (int w = 0; w < wid; ++w) woff += wt[w];
        const float base = incl - run + woff;
#pragma unroll
        for (int i = 0; i < 16; ++i) cl[tid * 16 + i] = (v[i] + base) * LOG2E;
    } else {
        if (tid < 128) tb[tid] = (relb[t5_bucket(tid) * 8 + (TYPE == 1 ? h : 4 + h)] - relb[31 * 8 + (TYPE == 1 ? h : 4 + h)]) * LOG2E;
        if constexpr (TYPE == 1) {
            float a = 0.f, c = 0.f;
            if (lane < 32) { a = dlam[lane] * dlam[32 + lane]; c = dlam[64 + lane] * dlam[96 + lane]; }
            a = wave_sum(a); c = wave_sum(c);
            lam = __expf(a) - __expf(c) + lam_init;
        }
    }
    asm volatile("s_waitcnt vmcnt(4)" ::: "memory");
    __syncthreads();
    const float tbfar = (TYPE == 0) ? 0.f : relb[31 * 8 + (TYPE == 1 ? h : 4 + h)] * LOG2E;
    const int xr = (r32 >> 1) & 7;
    int koff[4];
#pragma unroll
    for (int s = 0; s < 4; ++s) koff[s] = r32 * 128 + (((2 * s + hi) ^ xr) << 4);
    const int vrd = ((lane >> 4) & 1) * 32 + (lane & 3) * 8 + (4 * hi + ((lane & 15) >> 2)) * 64;
    float mA = 0.f, lA = 0.f, mB = 0.f, lB = 0.f;
    f32x16 oA[2], oB[2];
    oA[0] = f32x16{}; oA[1] = f32x16{}; oB[0] = f32x16{}; oB[1] = f32x16{};
#define ATT_TILE(kt, MWX, BAND) do { \
        const int slot = (kt) & 3; \
        unsigned long long mw = 0ull; \
        if constexpr (TYPE == 2) { asm volatile("" : "+v"(MWX)); mw = MWX; asm volatile("" : "+v"(mw)); ATT_MWLOAD(MWX, (kt) + 2); } \
        ATT_DMA((kt) + 3, ((kt) + 3) & 3); \
        const LAS unsigned char* kb = lds + L_K + slot * 8192; const LAS unsigned char* vb = lds + L_V + slot * 8192 + vrd; \
        {     \
            const float c0_ = tbfar - mA; f32x16 s0, s1; \
            _Pragma("unroll") for (int r = 0; r < 16; ++r) { s0[r] = c0_; s1[r] = c0_; } \
            _Pragma("unroll") for (int s = 0; s < (TYPE == 1 ? 2 : 4); ++s) { \
                const bf16x8 k0 = *(const LAS bf16x8*)(kb + koff[s]), k1 = *(const LAS bf16x8*)(kb + 4096 + koff[s]); \
                const bf16x8 qv = (TYPE == 1) ? *(const LAS bf16x8*)(lds + L_Q + wid * 4096 + s * 1024 + lane * 16) : qf[s]; \
                s0 = __builtin_amdgcn_mfma_f32_32x32x16_bf16(k0, qv, s0, 0, 0, 0); s1 = __builtin_amdgcn_mfma_f32_32x32x16_bf16(k1, qv, s1, 0, 0, 0); \
            } \
            __builtin_amdgcn_sched_barrier(0); \
            bias_mask2<TYPE, BAND>(s0, s1, cl, tb, (kt), qg, qw0, hi, mw); \
            __builtin_amdgcn_sched_barrier(0); \
            u32x4 pk[4]; \
            softmax2(s0, s1, mA, lA, oA, pk); \
            __builtin_amdgcn_sched_barrier(0); \
            pv_step(oA, pk, vb); \
        } \
        if constexpr (TYPE == 1) {     \
            __builtin_amdgcn_sched_barrier(0); \
            const float c0_ = tbfar - mB; f32x16 s0, s1; \
            _Pragma("unroll") for (int r = 0; r < 16; ++r) { s0[r] = c0_; s1[r] = c0_; } \
            _Pragma("unroll") for (int s = 2; s < 4; ++s) { \
                const bf16x8 k0 = *(const LAS bf16x8*)(kb + koff[s]), k1 = *(const LAS bf16x8*)(kb + 4096 + koff[s]); \
                const bf16x8 qv = *(const LAS bf16x8*)(lds + L_Q + wid * 4096 + s * 1024 + lane * 16); \
                s0 = __builtin_amdgcn_mfma_f32_32x32x16_bf16(k0, qv, s0, 0, 0, 0); s1 = __builtin_amdgcn_mfma_f32_32x32x16_bf16(k1, qv, s1, 0, 0, 0); \
            } \
            __builtin_amdgcn_sched_barrier(0); \
            bias_mask2<TYPE, BAND>(s0, s1, cl, tb, (kt), qg, qw0, hi, mw); \
            __builtin_amdgcn_sched_barrier(0); \
            u32x4 pk[4]; \
            softmax2(s0, s1, mB, lB, oB, pk); \
            __builtin_amdgcn_sched_barrier(0); \
            pv_step(oB, pk, vb); \
        } \
          \
        if constexpr (TYPE == 2) ATT_WAITBAR(5); else ATT_WAITBAR(4); \
    } while (0)
#define ATT_QK(S0, S1, kb_, mref) do { const float c0_ = tbfar - (mref); \
            _Pragma("unroll") for (int r = 0; r < 16; ++r) { S0[r] = c0_; S1[r] = c0_; } \
            _Pragma("unroll") for (int s = 0; s < 4; ++s) { \
                const bf16x8 k0 = *(const LAS bf16x8*)((kb_) + koff[s]), k1 = *(const LAS bf16x8*)((kb_) + 4096 + koff[s]); \
                S0 = __builtin_amdgcn_mfma_f32_32x32x16_bf16(k0, qf[s], S0, 0, 0, 0); S1 = __builtin_amdgcn_mfma_f32_32x32x16_bf16(k1, qf[s], S1, 0, 0, 0); } } while (0)
#define ATT_TILE2(kt, BAND) do { \
        const int slotA = sl2, slotB = sl2 + 1;        \
        unsigned long long mwa = 0ull, mwb = 0ull; \
        if constexpr (TYPE == 2) { asm volatile("" : "+v"(mwE), "+v"(mwO)); mwa = mwE; mwb = mwO; asm volatile("" : "+v"(mwa), "+v"(mwb)); ATT_MWLOAD(mwE, (kt) + 2); ATT_MWLOAD(mwO, (kt) + 3); } \
        ATT_DMA((kt) + 4, ATT_WRAP(sl2 + 4)); ATT_DMA((kt) + 5, ATT_WRAP(sl2 + 5)); \
        const LAS unsigned char* kbA = lds + L_K + slotA * 8192; const LAS unsigned char* vbA = lds + L_V + slotA * 8192 + vrd; \
        const LAS unsigned char* kbB = lds + L_K + slotB * 8192; const LAS unsigned char* vbB = lds + L_V + slotB * 8192 + vrd; \
        f32x16 a0, a1, b0, b1; \
        ATT_QK(a0, a1, kbA, mA); ATT_QK(b0, b1, kbB, mA); \
        { bias_mask2<TYPE, BAND>(a0, a1, cl, tb, (kt), qg, qw0, hi, mwa); u32x4 pk[4]; const float mold = mA; softmax2(a0, a1, mA, lA, oA, pk); \
          const float dm = mA - mold; if (__any(dm != 0.f)) { _Pragma("unroll") for (int r = 0; r < 16; ++r) { b0[r] -= dm; b1[r] -= dm; } }     \
          pv_step(oA, pk, vbA); } \
        { bias_mask2<TYPE, BAND>(b0, b1, cl, tb, (kt) + 1, qg, qw0, hi, mwb); u32x4 pk[4]; softmax2(b0, b1, mA, lA, oA, pk); pv_step(oA, pk, vbB); } \
          \
        ATT_WAITBAR(4); sl2 = ATT_WRAP(sl2 + 2); \
    } while (0)
#define SB_ __builtin_amdgcn_sched_barrier(0)
#define ATT_RDK(s_) do { kx0 = *(const LAS bf16x8*)(kbB + koff[s_]); kx1 = *(const LAS bf16x8*)(kbB + 4096 + koff[s_]); } while (0)
#define ATT_MMB(s_) do { b0 = __builtin_amdgcn_mfma_f32_32x32x16_bf16(kx0, qf[s_], b0, 0, 0, 0); b1 = __builtin_amdgcn_mfma_f32_32x32x16_bf16(kx1, qf[s_], b1, 0, 0, 0); } while (0)
#define ATT_RDV(vb_, db_, s0_) do { _Pragma("unroll") for (int i = 0; i < 2; ++i) { vl[i] = vtr((vb_) + (db_) * 4096 + ((s0_) + i) * 1024); vh[i] = vtr((vb_) + (db_) * 4096 + ((s0_) + i) * 1024 + 512); } } while (0)
#define ATT_MMV(pk_, db_, s0_) do { _Pragma("unroll") for (int i = 0; i < 2; ++i) { \
        const bf16x8 vf = (bf16x8){vl[i][0], vl[i][1], vl[i][2], vl[i][3], vh[i][0], vh[i][1], vh[i][2], vh[i][3]}; \
        oA[db_] = __builtin_amdgcn_mfma_f32_32x32x16_bf16(vf, __builtin_bit_cast(bf16x8, pk_[(s0_) + i]), oA[db_], 0, 0, 0); } } while (0)
#define ATT_BIAS(S0, S1, kt_, mw_) do { \
        if constexpr (TYPE == 0) { const int kbase = (kt_) * 64 + 4 * hi; \
            _Pragma("unroll") for (int g = 0; g < 4; ++g) { const f32x4 c0 = *(const LAS f32x4*)(cl + kbase + 8 * g), c1 = *(const LAS f32x4*)(cl + kbase + 32 + 8 * g); \
                _Pragma("unroll") for (int j = 0; j < 4; ++j) { S0[4 * g + j] -= c0[j]; S1[4 * g + j] -= c1[j]; } } \
        } else { const unsigned mlo = (unsigned)(mw_) >> (4 * hi), mhi = (unsigned)((mw_) >> 32) >> (4 * hi); \
            _Pragma("unroll") for (int r = 0; r < 16; ++r) { const int c = (r & 3) + 8 * (r >> 2); if (!((mlo >> c) & 1u)) S0[r] = -INFINITY; if (!((mhi >> c) & 1u)) S1[r] = -INFINITY; } } } while (0)
#define ATT_RMAX(rm_, S0, S1) do { float a = fmaxf(fmaxf(S0[0], S0[1]), S1[0]), c = fmaxf(fmaxf(S0[2], S0[3]), S1[1]); a = fmaxf(fmaxf(a, S1[2]), S1[3]); \
        _Pragma("unroll") for (int r = 4; r < 16; r += 4) { a = fmaxf(fmaxf(a, S0[r]), S0[r + 1]); c = fmaxf(fmaxf(c, S0[r + 2]), S0[r + 3]); a = fmaxf(fmaxf(a, S1[r]), S1[r + 1]); c = fmaxf(fmaxf(c, S1[r + 2]), S1[r + 3]); } \
        rm_ = fmaxf(a, c); rm_ = fmaxf(rm_, __shfl_xor(rm_, 32)); } while (0)
#define ATT_EXPH(S, pk0_, pk1_) do { _Pragma("unroll") for (int r = 0; r < 16; ++r) { S[r] = __builtin_amdgcn_exp2f(S[r]); rsum += S[r]; } \
        _Pragma("unroll") for (int i = 0; i < 4; ++i) { pk0_[i] = cvtpk(S[2 * i], S[2 * i + 1]); pk1_[i] = cvtpk(S[8 + 2 * i], S[8 + 2 * i + 1]); } } while (0)
#define ATT_FAST2(kt) do { \
        const int slotA = sl2, slotB = sl2 + 1; \
        unsigned long long mwa = 0ull, mwb = 0ull; \
        if constexpr (TYPE == 2) { asm volatile("" : "+v"(mwE), "+v"(mwO)); mwa = mwE; mwb = mwO; asm volatile("" : "+v"(mwa), "+v"(mwb)); ATT_MWLOAD(mwE, (kt) + 2); ATT_MWLOAD(mwO, (kt) + 3); } \
        ATT_DMA((kt) + 4, ATT_WRAP(sl2 + 4)); ATT_DMA((kt) + 5, ATT_WRAP(sl2 + 5)); \
        const LAS unsigned char* kbA = lds + L_K + slotA * 8192; const LAS unsigned char* vbA = lds + L_V + slotA * 8192 + vrd; \
        const LAS unsigned char* kbB = lds + L_K + slotB * 8192; const LAS unsigned char* vbB = lds + L_V + slotB * 8192 + vrd; \
        f32x16 a0, a1, b0, b1; u32x4 pkA[4], pkB[4]; float rma, rmb, rsum = 0.f; bf16x8 kx0, kx1; s16x4 vl[2], vh[2]; \
        ATT_RDK(0); \
        ATT_QK(a0, a1, kbA, mA); \
        { const float c0_ = tbfar - mA; _Pragma("unroll") for (int r = 0; r < 16; ++r) { b0[r] = c0_; b1[r] = c0_; } } \
        SB_; ATT_MMB(0); ATT_RDK(1); SB_; ATT_BIAS(a0, a1, (kt), mwa); SB_; ATT_MMB(1); ATT_RDK(2); SB_; ATT_RMAX(rma, a0, a1); SB_; \
        ATT_MMB(2); ATT_RDK(3); SB_; ATT_EXPH(a0, pkA[0], pkA[1]); SB_; ATT_MMB(3); ATT_RDV(vbA, 0, 0); SB_; ATT_EXPH(a1, pkA[2], pkA[3]); SB_; \
        ATT_MMV(pkA, 0, 0); ATT_RDV(vbA, 0, 2); SB_; ATT_BIAS(b0, b1, (kt) + 1, mwb); SB_; ATT_MMV(pkA, 0, 2); ATT_RDV(vbA, 1, 0); SB_; ATT_RMAX(rmb, b0, b1); SB_; \
        ATT_MMV(pkA, 1, 0); ATT_RDV(vbA, 1, 2); SB_; ATT_EXPH(b0, pkB[0], pkB[1]); SB_; ATT_MMV(pkA, 1, 2); ATT_RDV(vbB, 0, 0); SB_; ATT_EXPH(b1, pkB[2], pkB[3]); SB_; \
        ATT_MMV(pkB, 0, 0); ATT_RDV(vbB, 0, 2); SB_; ATT_MMV(pkB, 0, 2); ATT_RDV(vbB, 1, 0); SB_; ATT_MMV(pkB, 1, 0); ATT_RDV(vbB, 1, 2); SB_; ATT_MMV(pkB, 1, 2); \
        lA += rsum; \
        { const float rm = fmaxf(rma, rmb); \
          if (__any(rm > ATT_THR)) { const float d = fmaxf(rm, 0.f); mA += d; const float f = __builtin_amdgcn_exp2f(-d); lA *= f; \
              _Pragma("unroll") for (int r = 0; r < 16; ++r) { oA[0][r] *= f; oA[1][r] *= f; } } } \
        ATT_WAITBAR(4); sl2 = ATT_WRAP(sl2 + 2); \
    } while (0)
#define ATT_EXPD(S, pk0_, pk1_, rs_) do { _Pragma("unroll") for (int r = 0; r < 16; ++r) { S[r] = __builtin_amdgcn_exp2f(S[r]); rs_ += S[r]; } \
        _Pragma("unroll") for (int i = 0; i < 4; ++i) { pk0_[i] = cvtpk(S[2 * i], S[2 * i + 1]); pk1_[i] = cvtpk(S[8 + 2 * i], S[8 + 2 * i + 1]); } } while (0)
#define ATT_MMVO(O_, pk_, db_, s0_) do { _Pragma("unroll") for (int i = 0; i < 2; ++i) { \
        const bf16x8 vf = (bf16x8){vl[i][0], vl[i][1], vl[i][2], vl[i][3], vh[i][0], vh[i][1], vh[i][2], vh[i][3]}; \
        O_[db_] = __builtin_amdgcn_mfma_f32_32x32x16_bf16(vf, __builtin_bit_cast(bf16x8, pk_[(s0_) + i]), O_[db_], 0, 0, 0); } } while (0)
#define ATT_FASTD(kt) do { \
        const int slot = (kt) & 3; \
        ATT_DMA((kt) + 3, ((kt) + 3) & 3); \
        const LAS unsigned char* kb = lds + L_K + slot * 8192; const LAS unsigned char* vb = lds + L_V + slot * 8192 + vrd; \
        f32x16 a0, a1, b0, b1; u32x4 pkA[4], pkB[4]; float rma, rmb, rsa = 0.f, rsb = 0.f; bf16x8 kx0, kx1; s16x4 vl[2], vh[2]; \
        { const float ca_ = tbfar - mA, cb_ = tbfar - mB; _Pragma("unroll") for (int r = 0; r < 16; ++r) { a0[r] = ca_; a1[r] = ca_; b0[r] = cb_; b1[r] = cb_; } } \
        _Pragma("unroll") for (int s = 0; s < 2; ++s) { const bf16x8 k0 = *(const LAS bf16x8*)(kb + koff[s]), k1 = *(const LAS bf16x8*)(kb + 4096 + koff[s]); \
            a0 = __builtin_amdgcn_mfma_f32_32x32x16_bf16(k0, qf[s], a0, 0, 0, 0); a1 = __builtin_amdgcn_mfma_f32_32x32x16_bf16(k1, qf[s], a1, 0, 0, 0); } \
        kx0 = *(const LAS bf16x8*)(kb + koff[2]); kx1 = *(const LAS bf16x8*)(kb + 4096 + koff[2]); \
        SB_; b0 = __builtin_amdgcn_mfma_f32_32x32x16_bf16(kx0, qf[2], b0, 0, 0, 0); b1 = __builtin_amdgcn_mfma_f32_32x32x16_bf16(kx1, qf[2], b1, 0, 0, 0); \
        kx0 = *(const LAS bf16x8*)(kb + koff[3]); kx1 = *(const LAS bf16x8*)(kb + 4096 + koff[3]); SB_; ATT_RMAX(rma, a0, a1); SB_; \
        b0 = __builtin_amdgcn_mfma_f32_32x32x16_bf16(kx0, qf[3], b0, 0, 0, 0); b1 = __builtin_amdgcn_mfma_f32_32x32x16_bf16(kx1, qf[3], b1, 0, 0, 0); ATT_RDV(vb, 0, 0); SB_; ATT_EXPD(a0, pkA[0], pkA[1], rsa); SB_; \
        ATT_MMVO(oA, pkA, 0, 0); ATT_RDV(vb, 1, 0); SB_; ATT_EXPD(a1, pkA[2], pkA[3], rsa); SB_; \
        ATT_MMVO(oA, pkA, 1, 0); ATT_RDV(vb, 0, 2); SB_; ATT_RMAX(rmb, b0, b1); SB_; \
        ATT_MMVO(oA, pkA, 0, 2); ATT_RDV(vb, 1, 2); SB_; ATT_EXPD(b0, pkB[0], pkB[1], rsb); SB_; \
        ATT_MMVO(oA, pkA, 1, 2); ATT_RDV(vb, 0, 0); SB_; ATT_EXPD(b1, pkB[2], pkB[3], rsb); SB_; \
        ATT_MMVO(oB, pkB, 0, 0); ATT_RDV(vb, 0, 2); SB_; ATT_MMVO(oB, pkB, 0, 2); ATT_RDV(vb, 1, 0); SB_; ATT_MMVO(oB, pkB, 1, 0); ATT_RDV(vb, 1, 2); SB_; ATT_MMVO(oB, pkB, 1, 2); \
        lA += rsa; lB += rsb; \
        if (__any(rma > ATT_THR)) { const float d = fmaxf(rma, 0.f); mA += d; const float f = __builtin_amdgcn_exp2f(-d); lA *= f; \
            _Pragma("unroll") for (int r = 0; r < 16; ++r) { oA[0][r] *= f; oA[1][r] *= f; } } \
        if (__any(rmb > ATT_THR)) { const float d = fmaxf(rmb, 0.f); mB += d; const float f = __builtin_amdgcn_exp2f(-d); lB *= f; \
            _Pragma("unroll") for (int r = 0; r < 16; ++r) { oB[0][r] *= f; oB[1][r] *= f; } } \
        ATT_WAITBAR(4); \
    } while (0)
    int sl2 = 0;
    if constexpr (TYPE == 1) { const int nfarT = (q0 >= 176) ? ((q0 - 176) >> 6) + 1 : 0;
        int kt = 0; for (; kt < nfarT; ++kt) { ATT_FASTD(kt); } for (; kt < NT - 4; ++kt) { ATT_TILE(kt, mwE, false); } for (; kt < NT; ++kt) { ATT_TILE(kt, mwE, true); } }
    else if constexpr (TYPE == 0) { for (int kt = 0; kt < NT - 4; kt += 2) { ATT_FAST2(kt); } ATT_TILE2(NT - 4, true); ATT_TILE2(NT - 2, true); }
    else { const int nfarT = (q0 >= 176) ? ((q0 - 176) >> 6) + 1 : 0;
           int kt = 0; for (; kt + 2 <= nfarT; kt += 2) { ATT_FAST2(kt); } for (; kt < NT; kt += 2) { ATT_TILE2(kt, false); } }
    asm volatile("s_waitcnt vmcnt(0)" ::: "memory");
#undef ATT_TILE
#undef ATT_TILE2
#undef ATT_FASTD
#undef ATT_EXPD
#undef ATT_MMVO
#undef ATT_FAST2
#undef ATT_RDK
#undef ATT_MMB
#undef ATT_RDV
#undef ATT_MMV
#undef ATT_BIAS
#undef ATT_RMAX
#undef ATT_EXPH
#undef SB_
#undef ATT_QK
#undef ATT_DMA
#undef ATT_WAITBAR
#undef ATT_WRAP
#undef ATT_MWLOAD
    lA += __shfl_xor(lA, 32); const float iA = 1.0f / lA;
    bf16_t* yp = y + (rowbase + qg) * 1024 + TYPE * 256 + h * 64 + 4 * hi;
    if constexpr (TYPE == 1) {
        lB += __shfl_xor(lB, 32); const float iB = lam / lB;
        float ss = 0.f;
#pragma unroll
        for (int db = 0; db < 2; ++db)
#pragma unroll
            for (int r = 0; r < 16; ++r) { const float v = oA[db][r] * iA - oB[db][r] * iB; oA[db][r] = v; ss += v * v; }
        ss += __shfl_xor(ss, 32);
        const float rn = rsqrtf(ss * (1.0f / 64.0f) + LN_EPS) * (1.0f - lam_init);
#pragma unroll
        for (int db = 0; db < 2; ++db)
#pragma unroll
            for (int g = 0; g < 4; ++g) { const f32x4 gv = *(const f32x4*)(dng + db * 32 + 8 * g + 4 * hi);
                u32x2 w; w.x = cvtpk(oA[db][4 * g] * rn * gv[0], oA[db][4 * g + 1] * rn * gv[1]); w.y = cvtpk(oA[db][4 * g + 2] * rn * gv[2], oA[db][4 * g + 3] * rn * gv[3]);
                *(u32x2*)(yp + db * 32 + 8 * g) = w; }
    } else {
#pragma unroll
        for (int db = 0; db < 2; ++db)
#pragma unroll
            for (int g = 0; g < 4; ++g) { u32x2 w; w.x = cvtpk(oA[db][4 * g] * iA, oA[db][4 * g + 1] * iA); w.y = cvtpk(oA[db][4 * g + 2] * iA, oA[db][4 * g + 3] * iA);
                *(u32x2*)(yp + db * 32 + 8 * g) = w; }
    }
    __syncthreads();
}
}

namespace idx {
constexpr int IDX_KST = 73728;
__device__ __forceinline__ unsigned key16(float v) { v = v + 0.0f; const unsigned x = (unsigned)__builtin_bit_cast(unsigned short, (_Float16)v); return x ^ ((x & 0x8000u) ? 0xffffu : 0x8000u); }

__device__ __forceinline__ void topk_query(const unsigned short* __restrict__ srow, int q, LAS unsigned* kq, LAS unsigned* hist, unsigned long long& w0, unsigned long long& w1, int lane) {
    const int nreg = (q >> 7) + 1;
    const unsigned c3 = (unsigned)lane % 3u;
#pragma unroll
    for (int i = 0; i < 3; ++i) *(LAS u32x4*)(hist + lane * 12 + i * 4) = (u32x4){0u, 0u, 0u, 0u};
    LDS_WAIT();
    const __amdgpu_buffer_rsrc_t rsrc = __builtin_amdgcn_make_buffer_rsrc((void*)srow, 0, 8192 * 2, 0x00020000);
    for (int j0 = 0; j0 < nreg; j0 += 8) {
        unsigned w[8];
#pragma unroll
        for (int i = 0; i < 8; ++i) w[i] = __builtin_amdgcn_raw_buffer_load_b32(rsrc, lane * 4 + (j0 + i) * 256, 0, 0);
#pragma unroll
        for (int i = 0; i < 8; ++i) { const int j = j0 + i;
            const unsigned lo = (lane + 128 * j <= q) ? (w[i] & 0xffffu) : 0u, hi = (lane + 128 * j + 64 <= q) ? (w[i] & 0xffff0000u) : 0u;
            if (j < 64) kq[64 * j + lane] = lo | hi;
            if (lo) __hip_atomic_fetch_add(hist + (lo >> 8) * 3u + c3, 1u, __ATOMIC_RELAXED, __HIP_MEMORY_SCOPE_WORKGROUP);
            if (hi) __hip_atomic_fetch_add(hist + (hi >> 24) * 3u + c3, 1u, __ATOMIC_RELAXED, __HIP_MEMORY_SCOPE_WORKGROUP); }
    }
    unsigned need = 256u, prefix = 0u;
#pragma unroll 1
    for (int pass = 0; pass < 2; ++pass) {
        if (pass == 1) {
#pragma unroll
            for (int i = 0; i < 3; ++i) *(LAS u32x4*)(hist + lane * 12 + i * 4) = (u32x4){0u, 0u, 0u, 0u};
            LDS_WAIT();
            for (int j0 = 0; j0 < nreg; j0 += 4) { unsigned w[4];
#pragma unroll
                for (int i = 0; i < 4; ++i) w[i] = kq[64 * (j0 + i) + lane];
#pragma unroll
                for (int i = 0; i < 4; ++i) { const unsigned wv = (j0 + i < nreg) ? w[i] : 0u; const unsigned lo = wv & 0xffffu, hi = wv >> 16;
                    if ((lo >> 8) == prefix) __hip_atomic_fetch_add(hist + (lo & 255u) * 3u + c3, 1u, __ATOMIC_RELAXED, __HIP_MEMORY_SCOPE_WORKGROUP);
                    if ((hi >> 8) == prefix) __hip_atomic_fetch_add(hist + (hi & 255u) * 3u + c3, 1u, __ATOMIC_RELAXED, __HIP_MEMORY_SCOPE_WORKGROUP); } }
        }
        LDS_WAIT();
        u32x4 cv;
        { const u32x4 h0 = *(const LAS u32x4*)(hist + lane * 12), h1 = *(const LAS u32x4*)(hist + lane * 12 + 4), h2 = *(const LAS u32x4*)(hist + lane * 12 + 8);
          cv[0] = h0[0] + h0[1] + h0[2]; cv[1] = h0[3] + h1[0] + h1[1]; cv[2] = h1[2] + h1[3] + h2[0]; cv[3] = h2[1] + h2[2] + h2[3]; }
        const unsigned tot = (cv[0] + cv[1]) + (cv[2] + cv[3]);
        unsigned incl = tot;
#pragma unroll
        for (int off = 1; off < 64; off <<= 1) { const unsigned yv = __shfl_down(incl, off); if (lane + off < 64) incl += yv; }
        const unsigned a3 = incl - tot, a2 = a3 + cv[3], a1 = a2 + cv[2], a0 = a1 + cv[1];
        int dsel = -1; unsigned ab = 0u;
        if (a3 < need && a3 + cv[3] >= need) { dsel = 4 * lane + 3; ab = a3; }
        else if (a2 < need && a2 + cv[2] >= need) { dsel = 4 * lane + 2; ab = a2; }
        else if (a1 < need && a1 + cv[1] >= need) { dsel = 4 * lane + 1; ab = a1; }
        else if (a0 < need && a0 + cv[0] >= need) { dsel = 4 * lane + 0; ab = a0; }
        const unsigned long long fm = __ballot(dsel >= 0);
        const int src = fm ? (__ffsll((long long)fm) - 1) : 0;
        const unsigned dd = (unsigned)__shfl(dsel, src) & 255u, abb = (unsigned)__shfl((int)ab, src);
        need -= abb; prefix = (prefix << 8) | dd;
        LDS_WAIT();
    }
    LAS unsigned long long* wout = (LAS unsigned long long*)hist;
    *(LAS u32x4*)(hist + lane * 4) = (u32x4){0u, 0u, 0u, 0u};
    LDS_WAIT();
    unsigned run_eq = 0u;
    const unsigned long long ltmask = (lane == 0) ? 0ull : (~0ull >> (64 - lane));
    for (int j0 = 0; j0 < nreg; j0 += 4) { unsigned w[4];
#pragma unroll
        for (int i = 0; i < 4; ++i) w[i] = kq[64 * (j0 + i) + lane];
#pragma unroll
        for (int i = 0; i < 4; ++i) { const int j = j0 + i; const unsigned wv = (j < nreg) ? w[i] : 0u; const unsigned lo = wv & 0xffffu, hi = wv >> 16;
            unsigned long long sl = __ballot(lo > prefix), sh = __ballot(hi > prefix);
            const unsigned long long el = __ballot(lo == prefix), eh = __ballot(hi == prefix);
            if (el | eh) {
                const unsigned rl = run_eq + (unsigned)__popcll(el & ltmask); run_eq += (unsigned)__popcll(el);
                const unsigned rh = run_eq + (unsigned)__popcll(eh & ltmask); run_eq += (unsigned)__popcll(eh);
                sl |= __ballot((lo == prefix) && rl < need); sh |= __ballot((hi == prefix) && rh < need);
            }
            if (lane == 0 && j < 64) { wout[2 * j] = sl; wout[2 * j + 1] = sh; } } }
    LDS_WAIT();
    w0 = wout[lane]; w1 = wout[64 + lane];
    LDS_WAIT();
}

__device__ __forceinline__ void tile(LAS unsigned char* lds, const bf16_t* __restrict__ proj, unsigned short* __restrict__ scr, unsigned long long* __restrict__ sel, int b, int jt, const int tid_) {
    int tid = tid_; asm volatile("" : "+v"(tid));
    const int lane = tid & 63, r32 = lane & 31, hi = lane >> 5;
    const int wid = __builtin_amdgcn_readfirstlane(tid >> 6);
    const size_t rowbase = (size_t)b * SEQ; const int q0 = jt * 32; const int g = wid & 3, p = wid >> 2;
    if (q0 >= 256) {
        bf16x8 af[4];
        { const bf16_t* ap = proj + (rowbase + q0 + 8 * g + (r32 >> 2)) * PW + C_IQ + (r32 & 3) * 64 + 8 * hi;
#pragma unroll
          for (int s = 0; s < 4; ++s) af[s] = *(const bf16x8*)(ap + 16 * s); }
        float cw[16];
#pragma unroll
        for (int r = 0; r < 16; ++r) cw[r] = bf2f(proj[(rowbase + q0 + 8 * g + 2 * (r >> 2) + hi) * PW + C_IW + (r & 3)]) * 0.0625f;
        const int nkt = jt + 1;
        const int nround = (nkt + 3) >> 2;
        const unsigned lds0 = (unsigned)(__UINTPTR_TYPE__)lds;
        const bf16_t* dsrc; const bf16_t* dsrc2;
        { const int row = 16 * wid + (lane >> 3), c = (lane & 7) ^ ((row >> 1) & 7), c2 = (lane & 7) ^ (((row + 8) >> 1) & 7);
          dsrc = proj + (rowbase + row) * PW + C_IK + c * 8; dsrc2 = proj + (rowbase + row + 8) * PW + C_IK + c2 * 8; }
#define IDX_DMA(rnd) do { const int rc_ = min((rnd), nround - 1); const unsigned so_ = lds0 + (unsigned)(((rnd) & 3) * 16384 + wid * 2048); \
        glds16(dsrc + (size_t)rc_ * 128 * PW, (unsigned)__builtin_amdgcn_readfirstlane((int)so_)); glds16(dsrc2 + (size_t)rc_ * 128 * PW, (unsigned)__builtin_amdgcn_readfirstlane((int)(so_ + 1024u))); } while (0)
        const int frow = p * 32 + r32;
        int frd[4];
#pragma unroll
        for (int s = 0; s < 4; ++s) frd[s] = frow * 128 + (((2 * s + hi) ^ ((frow >> 1) & 7)) << 4);
        IDX_DMA(0); IDX_DMA(1); IDX_DMA(2);
        asm volatile("s_waitcnt vmcnt(4)\n\ts_barrier" ::: "memory");
        for (int rnd = 0; rnd < nround; ++rnd) {
            IDX_DMA(rnd + 3);
            const LAS unsigned char* kb = lds + (rnd & 3) * 16384;
            f32x16 acca = f32x16{}, accb = f32x16{};
#pragma unroll
            for (int s = 0; s < 4; ++s) { acca = __builtin_amdgcn_mfma_f32_32x32x16_bf16(af[s], *(const LAS bf16x8*)(kb + frd[s]), acca, 0, 0, 0);
                                          accb = __builtin_amdgcn_mfma_f32_32x32x16_bf16(af[s], *(const LAS bf16x8*)(kb + 8192 + frd[s]), accb, 0, 0, 0); }
            const int dw = 64 * rnd + 32 * p + r32;
#pragma unroll
            for (int qi = 0; qi < 4; ++qi) {
                float sa = 0.f, sb = 0.f;
#pragma unroll
                for (int hh = 0; hh < 4; ++hh) { sa += cw[4 * qi + hh] * fmaxf(acca[4 * qi + hh], 0.f); sb += cw[4 * qi + hh] * fmaxf(accb[4 * qi + hh], 0.f); }
                ((unsigned*)scr)[(size_t)(8 * g + 2 * qi + hi) * 4096 + dw] = key16(sa) | (key16(sb) << 16);
            }
            if (rnd == 0) asm volatile("s_waitcnt vmcnt(8) lgkmcnt(0)\n\ts_barrier" ::: "memory");
            else if (rnd == 1) asm volatile("s_waitcnt vmcnt(12) lgkmcnt(0)\n\ts_barrier" ::: "memory");
            else asm volatile("s_waitcnt vmcnt(16) lgkmcnt(0)\n\ts_barrier" ::: "memory");
        }
        asm volatile("s_waitcnt vmcnt(0)" ::: "memory");
#undef IDX_DMA
    }
    __syncthreads();
    LAS unsigned* kq = (LAS unsigned*)lds + wid * 4096;
    LAS unsigned* hist = (LAS unsigned*)(lds + 135168) + wid * 768;
    unsigned long long wa[4], wb[4];
    if (q0 < 256) {
#pragma unroll
        for (int i = 0; i < 4; ++i) {
            const int q = q0 + 4 * wid + i;
            const int nb0 = q + 1 - 64 * lane;
            wa[i] = nb0 >= 64 ? ~0ull : (nb0 <= 0 ? 0ull : ((1ull << nb0) - 1ull)); wb[i] = 0ull;
        }
    } else {
#pragma unroll
        for (int i = 0; i < 4; ++i) { const int ql = 4 * wid + i, q = q0 + ql; topk_query(scr + (size_t)ql * 8192, q, kq, hist, wa[i], wb[i], lane); }
    }
    { unsigned long long* d0 = sel + ((size_t)b * 128 + lane) * SEQ + q0 + 4 * wid; unsigned long long* d1 = d0 + (size_t)64 * SEQ;
      *(u32x4*)d0 = (u32x4){(unsigned)wa[0], (unsigned)(wa[0] >> 32), (unsigned)wa[1], (unsigned)(wa[1] >> 32)}; *(u32x4*)(d0 + 2) = (u32x4){(unsigned)wa[2], (unsigned)(wa[2] >> 32), (unsigned)wa[3], (unsigned)(wa[3] >> 32)};
      *(u32x4*)d1 = (u32x4){(unsigned)wb[0], (unsigned)(wb[0] >> 32), (unsigned)wb[1], (unsigned)(wb[1] >> 32)}; *(u32x4*)(d1 + 2) = (u32x4){(unsigned)wb[2], (unsigned)(wb[2] >> 32), (unsigned)wb[3], (unsigned)(wb[3] >> 32)}; }
    __syncthreads();
}
}

__device__ __forceinline__ void conv_tile(LAS unsigned char* lds, const bf16_t* __restrict__ proj, bf16_t* __restrict__ y, const float* __restrict__ cwt, const float* __restrict__ cb,
                                          const float* __restrict__ lg, const float* __restrict__ lb, int b, int t0, const int tid) {
    const int lane = tid & 63; const int wid = __builtin_amdgcn_readfirstlane(tid >> 6);
    LAS float* hb = (LAS float*)lds;
    LAS float* ob = (LAS float*)(lds + 65536);
    const size_t rowbase = (size_t)b * SEQ;
    for (int idx = tid; idx < 62 * 32; idx += NTHR) {
        const int rr = idx >> 5, c8 = (idx & 31) * 8, t = t0 - 30 + rr;
        f32x4 h0 = {0.f, 0.f, 0.f, 0.f}, h1 = {0.f, 0.f, 0.f, 0.f};
        if (t >= 0) { const bf16_t* p = proj + (rowbase + t) * PW + C_CU + c8; const u32x4 av = *(const u32x4*)p, gv = *(const u32x4*)(p + 256);
#pragma unroll
            for (int i = 0; i < 2; ++i) { h0[2 * i] = __uint_as_float(av[i] << 16) * sigmoidf_(__uint_as_float(gv[i] << 16)); h0[2 * i + 1] = __uint_as_float(av[i] & 0xffff0000u) * sigmoidf_(__uint_as_float(gv[i] & 0xffff0000u));
                                          h1[2 * i] = __uint_as_float(av[2 + i] << 16) * sigmoidf_(__uint_as_float(gv[2 + i] << 16)); h1[2 * i + 1] = __uint_as_float(av[2 + i] & 0xffff0000u) * sigmoidf_(__uint_as_float(gv[2 + i] & 0xffff0000u)); } }
        *(LAS f32x4*)(hb + rr * 256 + c8) = h0; *(LAS f32x4*)(hb + rr * 256 + c8 + 4) = h1;
    }
    __syncthreads();
    { const int c = tid & 255, half = tid >> 8;
      float w[31], win[46];
#pragma unroll
      for (int j = 0; j < 31; ++j) w[j] = cwt[j * 256 + c];
      const float bias = cb[c];
#pragma unroll
      for (int j = 0; j < 46; ++j) win[j] = hb[(half * 16 + j) * 256 + c];
#pragma unroll
      for (int i = 0; i < 16; ++i) {
          float a = bias;
#pragma unroll
          for (int j = 0; j < 31; ++j) a += w[j] * win[i + j];
          ob[(half * 16 + i) * 256 + c] = a;
      } }
    __syncthreads();
    for (int i = 0; i < 4; ++i) {
        const int tt = wid * 4 + i;
        const f32x4 v = *(const LAS f32x4*)(ob + tt * 256 + lane * 4);
        const float mean = wave_sum((v[0] + v[1]) + (v[2] + v[3])) * (1.0f / 256.0f);
        const f32x4 d = v - mean;
        const float var = wave_sum((d[0] * d[0] + d[1] * d[1]) + (d[2] * d[2] + d[3] * d[3])) * (1.0f / 256.0f);
        const float rstd = rsqrtf(var + LN_EPS);
        const f32x4 gv = *(const f32x4*)(lg + lane * 4), bv = *(const f32x4*)(lb + lane * 4);
        float o[4];
#pragma unroll
        for (int j = 0; j < 4; ++j) { const float z = d[j] * rstd * gv[j] + bv[j]; o[j] = z * sigmoidf_(z); }
        u32x2 w2; w2.x = cvtpk(o[0], o[1]); w2.y = cvtpk(o[2], o[3]);
        *(u32x2*)(y + (rowbase + t0 + tt) * 1024 + 768 + lane * 4) = w2;
    }
    __syncthreads();
}

__device__ __forceinline__ void cvt_item(const float* __restrict__ src, int ldn, int ncol, bool valid, bf16_t* __restrict__ dtile, int k0, LAS unsigned char* wl, int lane) {
    float v[64];
#pragma unroll
    for (int j = 0; j < 64; ++j) v[j] = valid ? __builtin_nontemporal_load(src + (size_t)(k0 + j) * ldn + ncol) : 0.f;
#pragma unroll
    for (int c = 0; c < 8; ++c) { u32x4 w; w.x = cvtpk(v[8 * c], v[8 * c + 1]); w.y = cvtpk(v[8 * c + 2], v[8 * c + 3]); w.z = cvtpk(v[8 * c + 4], v[8 * c + 5]); w.w = cvtpk(v[8 * c + 6], v[8 * c + 7]);
        *(LAS u32x4*)(wl + lane * 144 + c * 16) = w; }
    LDS_WAIT();
#pragma unroll
    for (int i = 0; i < 8; ++i) { const int row = (lane >> 3) + 8 * i, ch = lane & 7; const u32x4 w = *(const LAS u32x4*)(wl + row * 144 + ch * 16);
        __builtin_nontemporal_store(w, (u32x4*)(dtile + (size_t)row * 1024 + k0 + ch * 8)); }
    LDS_WAIT();
}
__device__ __forceinline__ int win_src_col(int n) {
    if (n < 768) return n;
    if (n < 2624) return n + 4;
    if (n < 3136) return n + 8;
    if (n < 3140) return 768 + (n - 3136);
    if (n < 3144) return 2628 + (n - 3140);
    return -1;
}
constexpr int CV_I_GU = 32 * 16, CV_I_DN = 16 * 16, CV_ITEMS = NE * (CV_I_GU + CV_I_DN), CV_CH = 32, CV_NCH = CV_ITEMS / CV_CH, CV_TOTAL = DEPTH * CV_NCH, CW_CVQ = CW_Q + 40 * 64;
__device__ __forceinline__ void cvx_ptrs(int r, int lx, const float* __restrict__ w_gu, const float* __restrict__ w_down, bf16_t* __restrict__ WGU, bf16_t* __restrict__ WDN, int lane, const float*& src, int& ldn, bf16_t*& dst) {
    if (r < NE * CV_I_GU) { const int le = lx * NE + r / CV_I_GU, q = r % CV_I_GU, kb = q / 32, nb = q % 32; ldn = 2048;
        src = w_gu + ((size_t)le * 1024 + kb * 64) * 2048 + nb * 64; dst = WGU + ((size_t)le * 2048 + nb * 64) * 1024 + kb * 64; }
    else { r -= NE * CV_I_GU; const int le = lx * NE + r / CV_I_DN, q = r % CV_I_DN, kb = q / 16, nb = q % 16; ldn = 1024;
        src = w_down + ((size_t)le * 1024 + kb * 64) * 1024 + nb * 64; dst = WDN + ((size_t)le * 1024 + nb * 64) * 1024 + kb * 64; }
    src += (size_t)(16 * (lane >> 4)) * ldn + 4 * (lane & 15);
}
__device__ __forceinline__ void cvx_load(f32x4 (&v)[16], const float* __restrict__ p, int ldn) {
#pragma unroll
    for (int j = 0; j < 16; ++j) v[j] = __builtin_nontemporal_load((const f32x4*)(p + (size_t)j * ldn));
}
__device__ __forceinline__ void cvx_store(const f32x4 (&v)[16], bf16_t* __restrict__ dtile, LAS unsigned char* wl, int lane) {
    const int r4 = lane >> 4, c4 = lane & 15;
#pragma unroll
    for (int i = 0; i < 4; ++i) { u32x4 w0, w1;
        w0.x = cvtpk(v[0][i], v[1][i]); w0.y = cvtpk(v[2][i], v[3][i]); w0.z = cvtpk(v[4][i], v[5][i]); w0.w = cvtpk(v[6][i], v[7][i]);
        w1.x = cvtpk(v[8][i], v[9][i]); w1.y = cvtpk(v[10][i], v[11][i]); w1.z = cvtpk(v[12][i], v[13][i]); w1.w = cvtpk(v[14][i], v[15][i]);
        *(LAS u32x4*)(wl + (4 * c4 + i) * 144 + r4 * 32) = w0; *(LAS u32x4*)(wl + (4 * c4 + i) * 144 + r4 * 32 + 16) = w1; }
    LDS_WAIT();
#pragma unroll
    for (int i = 0; i < 8; ++i) { const int row = (lane >> 3) + 8 * i, ch = lane & 7; const u32x4 w = *(const LAS u32x4*)(wl + row * 144 + ch * 16);
        __builtin_nontemporal_store(w, (u32x4*)(dtile + (size_t)row * 1024 + ch * 8)); }
    LDS_WAIT();
}
__device__ __forceinline__ void cvx_chunk(int ch, const float* __restrict__ w_gu, const float* __restrict__ w_down, bf16_t* __restrict__ WGU, bf16_t* __restrict__ WDN, LAS unsigned char* wl, int wid, int lane) {
    const int lx = ch / CV_NCH, r0 = (ch % CV_NCH) * CV_CH + wid;
    const float* s0; const float* s1; bf16_t* d0; bf16_t* d1; int l0, l1;
    f32x4 va[16], vb[16];
    cvx_ptrs(r0, lx, w_gu, w_down, WGU, WDN, lane, s0, l0, d0); cvx_load(va, s0, l0);
    cvx_ptrs(r0 + NWAVES, lx, w_gu, w_down, WGU, WDN, lane, s1, l1, d1); cvx_load(vb, s1, l1);
    cvx_store(va, d0, wl, lane);
    cvx_ptrs(r0 + 2 * NWAVES, lx, w_gu, w_down, WGU, WDN, lane, s0, l0, d0); cvx_load(va, s0, l0);
    cvx_store(vb, d1, wl, lane);
    cvx_ptrs(r0 + 3 * NWAVES, lx, w_gu, w_down, WGU, WDN, lane, s1, l1, d1); cvx_load(vb, s1, l1);
    cvx_store(va, d0, wl, lane);
    cvx_store(vb, d1, wl, lane);
}

#ifndef PH_MASK
#define PH_MASK 0xFFFF
#endif
#define PHASE_ON(n) ((PH_MASK >> (n)) & 1)
#ifndef REPEAT_MASK
#define REPEAT_MASK 0
#endif
#define NREP(n) (1 + ((REPEAT_MASK >> (n)) & 1))
struct Args { const float* in[21]; float* out; unsigned char* ws; };

__device__ __forceinline__ int q_fetch(unsigned* ctr, volatile LAS int* bc, int tid) {
    __syncthreads();
    if (tid == 0) *bc = (int)__hip_atomic_fetch_add(ctr, 1u, __ATOMIC_RELAXED, __HIP_MEMORY_SCOPE_AGENT);
    __syncthreads();
    return __builtin_amdgcn_readfirstlane(*bc);
}

__device__ __forceinline__ int q_fetch_lim(unsigned* ctr, volatile LAS int* bc, int tid, unsigned limit) {
    __syncthreads();
    if (tid == 0) { const unsigned cur = __hip_atomic_load(ctr, __ATOMIC_RELAXED, __HIP_MEMORY_SCOPE_AGENT); *bc = (cur < limit) ? (int)__hip_atomic_fetch_add(ctr, 1u, __ATOMIC_RELAXED, __HIP_MEMORY_SCOPE_AGENT) : 0x7fffffff; }
    __syncthreads();
    return __builtin_amdgcn_readfirstlane(*bc);
}
__device__ __forceinline__ int q_fetch2(unsigned* ctr, unsigned* ctr2, volatile LAS int* bc, volatile LAS int* bc2, int tid, int& v2) {
    __syncthreads();
    if (tid == 0) { int t2 = 0x7fffffff; if (ctr2) t2 = (int)__hip_atomic_fetch_add(ctr2, 1u, __ATOMIC_RELAXED, __HIP_MEMORY_SCOPE_AGENT);
        *bc = (int)__hip_atomic_fetch_add(ctr, 1u, __ATOMIC_RELAXED, __HIP_MEMORY_SCOPE_AGENT); *bc2 = t2; }
    __syncthreads();
    v2 = __builtin_amdgcn_readfirstlane(*bc2);
    return __builtin_amdgcn_readfirstlane(*bc);
}
#define CVT_CHUNK(ch_) cvx_chunk((ch_), IN(15), IN(17), (bf16_t*)(ws + WS_WGU), (bf16_t*)(ws + WS_WDN), lds + wid * 9216, wid, lane)

typedef const __attribute__((address_space(4))) Args* ArgsP;
#define PHASE_PTRS() ArgsP ap_ = (ArgsP)__builtin_amdgcn_kernarg_segment_ptr(); asm volatile("" : "+s"(ap_)); unsigned char* ws = ap_->ws; unsigned* ctl = (unsigned*)(ws + WS_CTL); (void)ctl; int tid = wid0 * 64 + lane_id_(); asm volatile("" : "+v"(tid)); const int lane = tid & 63; const int wid = __builtin_amdgcn_readfirstlane(tid >> 6); (void)lane; (void)wid
#define IN(i) (ap_->in[i])

template <int layer>
__device__ __forceinline__ void run_layer(LAS unsigned char* lds, const XcdBarrier& bar, volatile LAS int* qbc, const int G, const int bid, const int wid0) {
        const float lam_init = (layer == 0) ? 0.2f : (layer == 1) ? 0.35550906759096934f : (layer == 2) ? 0.4707130183435842f : 0.5560582041556406f;
        _Pragma("unroll") for (int rep = 0; rep < NREP(1); ++rep) {
        PROBE_T0(1);
#if PHASE_ON(1)
    asm volatile("; PHASE_MARK 1");
        {
            PHASE_PTRS();
            pg8::DenseSched S; S.init((const bf16_t*)(ws + WS_XB), (const bf16_t*)(ws + WS_WIN) + (size_t)layer * PW * 1024, T, PW, G, bid);
            pg8::EpiProj E{(bf16_t*)(ws + WS_PROJ)};
            pg8::gemm_phase<pg8::EpiProj, pg8::DenseSched, true>(lds, S, E, tid);
            { constexpr int NU = (T / 256) * (PW / 256); if (NU % G != 0 && bid >= NU % G) { const int ch = q_fetch_lim(ctl + CW_CVQ, qbc, tid, CV_TOTAL); if (ch < CV_TOTAL) CVT_CHUNK(ch); } }
        }
#endif
        xcd_barrier(bar, wid0);
        PROBE_SPIN(1);
        }
        _Pragma("unroll") for (int rep = 0; rep < NREP(2); ++rep) {
        PROBE_T0(2);
#if PHASE_ON(2)
    asm volatile("; PHASE_MARK 2");
        {
            PHASE_PTRS();
            const bf16_t* PROJ = (const bf16_t*)(ws + WS_PROJ); bf16_t* Y = (bf16_t*)(ws + WS_Y); unsigned long long* SEL = (unsigned long long*)(ws + WS_SEL); unsigned short* SCR = (unsigned short*)(ws + WS_SCR) + (size_t)bid * 32 * 8192;
            const float* conv_w = IN(6); const float* conv_b = IN(7); const float* conv_ln_g = IN(8); const float* conv_ln_b = IN(9);
            { PROBE_T0(9);
            for (int u2 = bid * 2; u2 < 512; u2 += (u2 & 1) ? (2 * G - 1) : 1) { const int u = u2 >> 1, b = u >> 7, j = u & 127; idx::tile(lds, PROJ, SCR, SEL, b, (u2 & 1) ? 255 - j : j, tid); }
            PROBE_SPIN(9); }
            { PROBE_T0(10);
            for (int u = bid; u < T / 32; u += G) { const int b = u / (SEQ / 32), t0 = (u % (SEQ / 32)) * 32;
                conv_tile(lds, PROJ, Y, conv_w + (size_t)layer * 31 * 256, conv_b + layer * 256, conv_ln_g + layer * 256, conv_ln_b + layer * 256, b, t0, tid); }
            PROBE_SPIN(10); }
        }
#endif
        xcd_barrier(bar, wid0);
        PROBE_SPIN(2);
        }
        _Pragma("unroll") for (int rep = 0; rep < NREP(3); ++rep) {
        PROBE_T0(3);
#if PHASE_ON(3)
    asm volatile("; PHASE_MARK 3");
        {
            PHASE_PTRS();
            const bf16_t* PROJ = (const bf16_t*)(ws + WS_PROJ); bf16_t* Y = (bf16_t*)(ws + WS_Y); const unsigned long long* SEL = (const unsigned long long*)(ws + WS_SEL);
            const float* rel_bias = IN(1); const float* forget_b = IN(3); const float* diff_lambda = IN(4); const float* diff_norm_g = IN(5);
#ifndef ATT_MASK
#define ATT_MASK 7
#endif
            int npull_ = 0, nf_ = 0; volatile LAS int* qbc2 = (volatile LAS int*)(lds + LDS_MISC + 64);
            const int xq_ = (G % 8 == 0) ? 1 + (bid & 7) : 0, xn_ = (G % 8 == 0) ? 32 : 256;
            if (ATT_MASK & 4) for (;;) { int ch_; int u = q_fetch2(ctl + CW_Q + (layer * 8 + 2 + 4 * rep) * 64 + xq_, (nf_++ > 0 && npull_ < 3) ? ctl + CW_CVQ : nullptr, qbc, qbc2, tid, ch_); if (ch_ != 0x7fffffff) { ++npull_; if (ch_ < CV_TOTAL) { CVT_CHUNK(ch_); __syncthreads(); } } if (u >= xn_) break; if (xn_ == 32) u = u * 8 + (bid & 7); const int qb = 31 - (u >> 3), b = (u >> 2) & 1, h = u & 3;
                att::unit<2>(lds, PROJ, Y, SEL, rel_bias, 0.f, nullptr, 0.f, nullptr, b, h, qb, tid); }
            if (ATT_MASK & 1) for (;;) { int ch_; int u = q_fetch2(ctl + CW_Q + (layer * 8 + 0 + 4 * rep) * 64 + xq_, (nf_++ > 0 && npull_ < 3) ? ctl + CW_CVQ : nullptr, qbc, qbc2, tid, ch_); if (ch_ != 0x7fffffff) { ++npull_; if (ch_ < CV_TOTAL) { CVT_CHUNK(ch_); __syncthreads(); } } if (u >= xn_) break; if (xn_ == 32) u = u * 8 + (bid & 7); const int qb = 31 - (u >> 3), b = (u >> 2) & 1, h = u & 3;
                att::unit<1>(lds, PROJ, Y, SEL, rel_bias, 0.f, diff_lambda + layer * 128, lam_init, diff_norm_g + layer * 64, b, h, qb, tid); }
            if (ATT_MASK & 2) for (;;) { int ch_; int u = q_fetch2(ctl + CW_Q + (layer * 8 + 1 + 4 * rep) * 64 + xq_, (nf_++ > 0 && npull_ < 3) ? ctl + CW_CVQ : nullptr, qbc, qbc2, tid, ch_); if (ch_ != 0x7fffffff) { ++npull_; if (ch_ < CV_TOTAL) { CVT_CHUNK(ch_); __syncthreads(); } } if (u >= xn_) break; if (xn_ == 32) u = u * 8 + (bid & 7); const int qb = 31 - (u >> 3), b = (u >> 2) & 1, h = u & 3;
                att::unit<0>(lds, PROJ, Y, SEL, rel_bias, forget_b[layer * 4 + h], nullptr, 0.f, nullptr, b, h, qb, tid); }
            for (;;) { const int ch_ = q_fetch_lim(ctl + CW_CVQ, qbc, tid, CV_NCH * (layer + 1)); if (ch_ == 0x7fffffff) break; if (ch_ < CV_TOTAL) CVT_CHUNK(ch_); }
        }
#endif
        xcd_barrier(bar, wid0);
        PROBE_SPIN(3);
        }
        _Pragma("unroll") for (int rep = 0; rep < NREP(4); ++rep) {
        PROBE_T0(4);
#if PHASE_ON(4)
    asm volatile("; PHASE_MARK 4");
        {
            PHASE_PTRS();
            pg8::DenseSched S; S.init((const bf16_t*)(ws + WS_Y), (const bf16_t*)(ws + WS_WOUT) + (size_t)layer * 1024 * 1024, T, 1024, G, bid);
            pg8::EpiPre E{(const bf16_t*)(ws + WS_XB), (float*)(ws + WS_PRE)};
            pg8::gemm_phase<pg8::EpiPre, pg8::DenseSched, true>(lds, S, E, tid);
        }
#endif
        xcd_barrier(bar, wid0);
        PROBE_SPIN(4);
        }
        { PROBE_T0(5);
#if PHASE_ON(5)
    asm volatile("; PHASE_MARK 5");
        {
            PHASE_PTRS();
            const float* ln1_g = IN(11); const float* ln1_b = IN(12); const float* router_b = IN(14);
            const bf16_t* RWT = (const bf16_t*)(ws + WS_RWT); const float* PRE = (const float*)(ws + WS_PRE); bf16_t* X1B = (bf16_t*)(ws + WS_X1B);
            int* TOK = (int*)(ws + WS_TOK); int* PE = (int*)(ws + WS_PE); int* PS = PE + T * 4; float* PG = (float*)(PS + T * 4);
            LAS float* red = (LAS float*)lds;
            LAS float* part = (LAS float*)(lds + 1024);
            LAS int* lcnt = (LAS int*)(lds + 1024 + 32768);
            LAS int* lbase = lcnt + 32;
            LAS int* pe_ = lbase + 32;
            LAS int* pl_ = pe_ + 128;
            LAS float* pg_ = (LAS float*)(pl_ + 128);
            const int r32 = lane & 31, hi = lane >> 5;
            const float* g1 = ln1_g + layer * 1024; const float* b1 = ln1_b + layer * 1024;
            const bf16_t* rwh = RWT + (size_t)(layer * 2 + 0) * 32 * 1024; const bf16_t* rwl = RWT + (size_t)(layer * 2 + 1) * 32 * 1024;
            unsigned* ecnt = ctl + CW_ECNT + layer * 64;
            for (int u = bid; u < T / 32; u += G) {
                const int r0 = u * 32; const int kb0 = 128 * wid + 8 * hi;
                const float* pr = PRE + (size_t)(r0 + r32) * 1024 + kb0;
                f32x4 v[8][2];
                float s = 0.f;
#pragma unroll
                for (int si = 0; si < 8; ++si) { v[si][0] = *(const f32x4*)(pr + 16 * si); v[si][1] = *(const f32x4*)(pr + 16 * si + 4);
                    s += (v[si][0][0] + v[si][0][1]) + (v[si][0][2] + v[si][0][3]) + (v[si][1][0] + v[si][1][1]) + (v[si][1][2] + v[si][1][3]); }
                s += __shfl_xor(s, 32);
                if (tid < 32) lcnt[tid] = 0;
                if (hi == 0) red[wid * 32 + r32] = s;
                __syncthreads();
                float mean = 0.f;
#pragma unroll
                for (int w = 0; w < 8; ++w) mean += red[w * 32 + r32];
                mean *= (1.0f / 1024.0f);
                float s2 = 0.f;
#pragma unroll
                for (int si = 0; si < 8; ++si)
#pragma unroll
                    for (int j = 0; j < 2; ++j) { v[si][j] = v[si][j] - mean; s2 += (v[si][j][0] * v[si][j][0] + v[si][j][1] * v[si][j][1]) + (v[si][j][2] * v[si][j][2] + v[si][j][3] * v[si][j][3]); }
                s2 += __shfl_xor(s2, 32);
                __syncthreads();
                if (hi == 0) red[wid * 32 + r32] = s2;
                __syncthreads();
                float var = 0.f;
#pragma unroll
                for (int w = 0; w < 8; ++w) var += red[w * 32 + r32];
                const float rstd = rsqrtf(var * (1.0f / 1024.0f) + LN_EPS);
                f32x16 acc = f32x16{};
                bf16_t* xbo = X1B + (size_t)(r0 + r32) * 1024 + kb0;
#pragma unroll
                for (int si = 0; si < 8; ++si) {
                    u32x4 ah, al;
#pragma unroll
                    for (int j = 0; j < 2; ++j) {
                        const f32x4 gv = *(const f32x4*)(g1 + kb0 + 16 * si + 4 * j), bv = *(const f32x4*)(b1 + kb0 + 16 * si + 4 * j);
                        const f32x4 xv = v[si][j] * rstd * gv + bv;
                        const unsigned h0 = cvtpk(xv[0], xv[1]), h1 = cvtpk(xv[2], xv[3]);
                        const unsigned l0 = cvtpk(xv[0] - __uint_as_float(h0 << 16), xv[1] - __uint_as_float(h0 & 0xffff0000u)), l1 = cvtpk(xv[2] - __uint_as_float(h1 << 16), xv[3] - __uint_as_float(h1 & 0xffff0000u));
                        ah[2 * j] = h0; ah[2 * j + 1] = h1; al[2 * j] = l0; al[2 * j + 1] = l1;
                    }
                    *(u32x4*)(xbo + 16 * si) = ah;
                    const bf16x8 bh = *(const bf16x8*)(rwh + (size_t)r32 * 1024 + kb0 + 16 * si), bl = *(const bf16x8*)(rwl + (size_t)r32 * 1024 + kb0 + 16 * si);
                    acc = __builtin_amdgcn_mfma_f32_32x32x16_bf16(__builtin_bit_cast(bf16x8, ah), bh, acc, 0, 0, 0);
                    acc = __builtin_amdgcn_mfma_f32_32x32x16_bf16(__builtin_bit_cast(bf16x8, ah), bl, acc, 0, 0, 0);
                    acc = __builtin_amdgcn_mfma_f32_32x32x16_bf16(__builtin_bit_cast(bf16x8, al), bh, acc, 0, 0, 0);
                }
#pragma unroll
                for (int r = 0; r < 16; ++r) part[(wid * 32 + att::crow(r, hi)) * 32 + r32] = acc[r];
                __syncthreads();
#pragma unroll
                for (int rnd = 0; rnd < 2; ++rnd) {
                    const int tk = 4 * wid + 2 * rnd + hi;
                    float lg_ = router_b[layer * 32 + r32];
#pragma unroll
                    for (int w = 0; w < 8; ++w) lg_ += part[(w * 32 + tk) * 32 + r32];
                    float tv[4]; int te[4];
#pragma unroll
                    for (int k = 0; k < 4; ++k) {
                        const unsigned xb_ = __float_as_uint(lg_); const unsigned key = (xb_ & 0x80000000u) ? ~xb_ : (xb_ | 0x80000000u);
                        unsigned long long kk = ((unsigned long long)key << 32) | (unsigned)(31 - r32);
#pragma unroll
                        for (int o = 1; o < 32; o <<= 1) { const unsigned long long ot = __shfl_xor(kk, o); kk = ot > kk ? ot : kk; }
                        const int ew = 31 - (int)(kk & 31u);
                        const unsigned kx = (unsigned)(kk >> 32); const unsigned vb_ = (kx & 0x80000000u) ? (kx & 0x7fffffffu) : ~kx;
                        tv[k] = __uint_as_float(vb_); te[k] = ew;
                        if (r32 == ew) lg_ = -INFINITY;
                    }
                    const float e1 = __expf(tv[1] - tv[0]), e2 = __expf(tv[2] - tv[0]), e3 = __expf(tv[3] - tv[0]);
                    const float inv = 1.0f / (1.0f + e1 + e2 + e3);
                    if (r32 < 4) {
                        const int ee = r32 == 0 ? te[0] : r32 == 1 ? te[1] : r32 == 2 ? te[2] : te[3];
                        const float gg = (r32 == 0 ? 1.0f : r32 == 1 ? e1 : r32 == 2 ? e2 : e3) * inv;
                        const int lr = __hip_atomic_fetch_add(lcnt + ee, 1, __ATOMIC_RELAXED, __HIP_MEMORY_SCOPE_WORKGROUP);
                        pe_[tk * 4 + r32] = ee; pl_[tk * 4 + r32] = lr; pg_[tk * 4 + r32] = gg;
                    }
                }
                __syncthreads();
                if (tid < 32) { const int n = lcnt[tid]; lbase[tid] = n > 0 ? (int)__hip_atomic_fetch_add(ecnt + tid, (unsigned)n, __ATOMIC_RELAXED, __HIP_MEMORY_SCOPE_AGENT) : 0; }
                __syncthreads();
                if (tid < 128) { const int ee = pe_[tid], slot = lbase[ee] + pl_[tid], tok = r0 + (tid >> 2);
                    TOK[(size_t)ee * ECAP + slot] = tok; PE[tok * 4 + (tid & 3)] = ee; PS[tok * 4 + (tid & 3)] = slot; PG[tok * 4 + (tid & 3)] = pg_[tid]; }
                __syncthreads();
            }
        }
#endif
        xcd_barrier(bar, wid0);
        PROBE_SPIN(5); }
        LAS int* t_texp = (LAS int*)(lds + LDS_TAB);
        LAS int* t_tstart = t_texp + MAXTILES;
        LAS int* t_cnt = t_tstart + 36;
        {
            PHASE_PTRS();
            unsigned* ecnt = ctl + CW_ECNT + layer * 64;
            if (tid < 64) {
                const int n = (lane < NE) ? (int)__hip_atomic_load(ecnt + (lane & 31), __ATOMIC_RELAXED, __HIP_MEMORY_SCOPE_AGENT) : 0;
                const int nt_ = (n + 255) >> 8; int incl = nt_;
#pragma unroll
                for (int off = 1; off < 64; off <<= 1) { const int yv = __shfl_up(incl, off); if (lane >= off) incl += yv; }
                const int st_ = incl - nt_;
                if (lane < NE) { t_cnt[lane] = n; t_tstart[lane] = st_;
#pragma unroll 1
                    for (int j = 0; j < nt_; ++j) t_texp[st_ + j] = lane; }
                if (lane == NE) t_tstart[NE] = st_;
            }
            __syncthreads();
        }
        const int ntiles = __builtin_amdgcn_readfirstlane(t_tstart[NE]);
        pg8::MoeTabs tabs{t_texp, t_tstart, t_cnt, ntiles};
        pg8::MoeShift shf; shf.init(ntiles, G);
        _Pragma("unroll") for (int rep = 0; rep < NREP(6); ++rep) {
        PROBE_T0(6);
#if PHASE_ON(6)
    asm volatile("; PHASE_MARK 6");
        {
            PHASE_PTRS();
            LAS int* tokl = (LAS int*)(lds + pg8::VOFF_LDS + 8192);
            { const int* TOKg = (const int*)(ws + WS_TOK);
              pg8::MoeSchedA S0{nullptr, nullptr, nullptr, nullptr, nullptr, tabs, shf, G, bid};
              for (int i = 0; ; ++i) { pg8::Unit u0; if (!S0.next(i, u0) || u0.kind) break;
                  const int pm = u0.pm, e = u0.e; const int s_ = (pm - t_tstart[e]) * 256 + (tid & 255), n = t_cnt[e];
                  if (tid < 256) tokl[i * 256 + tid] = (s_ < n) ? TOKg[(size_t)e * ECAP + s_] : 0; }
              __syncthreads(); }
            pg8::MoeSchedA S{(const bf16_t*)(ws + WS_X1B), (const bf16_t*)(ws + WS_H), (const bf16_t*)(ws + WS_WGU) + (size_t)layer * NE * 2048 * 1024, (const bf16_t*)(ws + WS_WDN) + (size_t)layer * NE * 1024 * 1024, tokl, tabs, shf, G, bid};
            pg8::EpiMoe E{pg8::EpiSwiglu{(bf16_t*)(ws + WS_H), IN(16) + (size_t)layer * NE * 2048}, pg8::EpiDown{(bf16_t*)(ws + WS_Y2), IN(18) + (size_t)layer * NE * 1024}};
            pg8::gemm_phase<pg8::EpiMoe, pg8::MoeSchedA, true>(lds, S, E, tid);
        }
#endif
        xcd_barrier(bar, wid0);
        PROBE_SPIN(6);
        }
        _Pragma("unroll") for (int rep = 0; rep < NREP(7); ++rep) {
        PROBE_T0(7);
#if PHASE_ON(7)
    asm volatile("; PHASE_MARK 7");
        {
            PHASE_PTRS();
            pg8::MoeSchedB S{(const bf16_t*)(ws + WS_H), (const bf16_t*)(ws + WS_WDN) + (size_t)layer * NE * 1024 * 1024, tabs, shf, G, bid};
            pg8::EpiDown E{(bf16_t*)(ws + WS_Y2), IN(18) + (size_t)layer * NE * 1024};
            pg8::gemm_phase<pg8::EpiDown, pg8::MoeSchedB, true>(lds, S, E, tid);
        }
#endif
        xcd_barrier(bar, wid0);
        PROBE_SPIN(7);
        }
        { PROBE_T0(8);
#if PHASE_ON(8)
    asm volatile("; PHASE_MARK 8");
        {
            PHASE_PTRS();
            const float* g2 = IN(19) + layer * 1024; const float* b2 = IN(20) + layer * 1024;
            const bf16_t* X1B = (const bf16_t*)(ws + WS_X1B); const bf16_t* Y2 = (const bf16_t*)(ws + WS_Y2); bf16_t* XB = (bf16_t*)(ws + WS_XB);
            const int* PE = (const int*)(ws + WS_PE); const int* PS = PE + T * 4; const float* PG = (const float*)(PS + T * 4);
            float* xout = (layer == DEPTH - 1) ? ap_->out : (float*)(ws + WS_XF);
            for (int rb = (bid * NWAVES + wid) * 8; rb < T; rb += G * NWAVES * 8) {
                const int pe_v = (lane < 32) ? PE[rb * 4 + lane] : 0, ps_v = (lane < 32) ? PS[rb * 4 + lane] : 0; const float pg_v = (lane < 32) ? PG[rb * 4 + lane] : 0.f;
#pragma unroll 1
                for (int i = 0; i < 8; i += 2) {
                    f32x4 v[2][4]; u32x2 yw[2][4][4]; float gk[2][4];
#pragma unroll
                    for (int r = 0; r < 2; ++r) {
                        const int row = rb + i + r;
#pragma unroll
                        for (int j = 0; j < 4; ++j) { const u32x2 xw = *(const u32x2*)(X1B + (size_t)row * 1024 + lane * 4 + 256 * j); v[r][j] = f32x4{__builtin_bit_cast(float, xw.x << 16), __builtin_bit_cast(float, xw.x & 0xffff0000u), __builtin_bit_cast(float, xw.y << 16), __builtin_bit_cast(float, xw.y & 0xffff0000u)}; }
#pragma unroll
                        for (int k = 0; k < 4; ++k) {
                            const int li = (i + r) * 4 + k;
                            const int ee = __builtin_amdgcn_readlane(pe_v, li), slot = __builtin_amdgcn_readlane(ps_v, li); gk[r][k] = __builtin_bit_cast(float, __builtin_amdgcn_readlane(__builtin_bit_cast(int, pg_v), li));
                            const bf16_t* yr = Y2 + ((size_t)__builtin_amdgcn_readfirstlane(t_tstart[ee]) * 256 + slot) * 1024 + lane * 4;
#pragma unroll
                            for (int j = 0; j < 4; ++j) yw[r][k][j] = *(const u32x2*)(yr + 256 * j);
                        }
                    }
#pragma unroll
                    for (int r = 0; r < 2; ++r) {
                        const int row = rb + i + r;
#pragma unroll
                        for (int j = 0; j < 4; ++j) v[r][j] = v[r][j] * DN_ALPHA;
#pragma unroll
                        for (int k = 0; k < 4; ++k) { const float gg = gk[r][k];
#pragma unroll
                            for (int j = 0; j < 4; ++j) { const u32x2 w = yw[r][k][j];
                                v[r][j][0] += gg * __uint_as_float(w.x << 16); v[r][j][1] += gg * __uint_as_float(w.x & 0xffff0000u); v[r][j][2] += gg * __uint_as_float(w.y << 16); v[r][j][3] += gg * __uint_as_float(w.y & 0xffff0000u); } }
                        float s_ = 0.f;
#pragma unroll
                        for (int j = 0; j < 4; ++j) s_ += (v[r][j][0] + v[r][j][1]) + (v[r][j][2] + v[r][j][3]);
                        const float mean = wave_sum(s_) * (1.0f / 1024.0f);
                        float s2 = 0.f;
#pragma unroll
                        for (int j = 0; j < 4; ++j) { v[r][j] = v[r][j] - mean; s2 += (v[r][j][0] * v[r][j][0] + v[r][j][1] * v[r][j][1]) + (v[r][j][2] * v[r][j][2] + v[r][j][3] * v[r][j][3]); }
                        const float rstd = rsqrtf(wave_sum(s2) * (1.0f / 1024.0f) + LN_EPS);
#pragma unroll
                        for (int j = 0; j < 4; ++j) {
                            const f32x4 gv = *(const f32x4*)(g2 + lane * 4 + 256 * j), bv = *(const f32x4*)(b2 + lane * 4 + 256 * j);
                            const f32x4 o = v[r][j] * rstd * gv + bv;
                            if constexpr (layer == DEPTH - 1) *(f32x4*)(xout + (size_t)row * 1024 + lane * 4 + 256 * j) = o;
                            u32x2 w; w.x = cvtpk(o[0], o[1]); w.y = cvtpk(o[2], o[3]);
                            *(u32x2*)(XB + (size_t)row * 1024 + lane * 4 + 256 * j) = w;
                        }
                    }
                }
            }
        }
#endif
        if (layer + 1 < DEPTH) xcd_barrier(bar, wid0);
        PROBE_SPIN(8); }
}

__global__ void __launch_bounds__(NTHR, 2) mega_fwd(Args args) {
    extern __shared__ __attribute__((aligned(16))) unsigned char lds_raw[];
    LAS unsigned char* lds = (LAS unsigned char*)lds_raw;
    const int G = gridDim.x, bid = blockIdx.x;
    volatile LAS unsigned* misc = (volatile LAS unsigned*)(lds + LDS_MISC);
    const int wid0 = __builtin_amdgcn_readfirstlane((int)threadIdx.x >> 6);
    if (threadIdx.x < 16) misc[threadIdx.x] = 0u;
    __syncthreads();
    XcdBarrier bar = xcd_barrier_post((unsigned*)(args.ws + WS_CTL) + CW_BAR, misc, (int)threadIdx.x);
    volatile LAS int* qbc = (volatile LAS int*)(lds + LDS_MISC + 16);

    { PROBE_T0(0);
#if PHASE_ON(0)
    asm volatile("; PHASE_MARK 0");
    {
        PHASE_PTRS();
        const float* x_in = IN(0); const float* w_in = IN(2); const float* w_out = IN(10); const float* router_w = IN(13); const float* w_gu = IN(15); const float* w_down = IN(17);
        bf16_t* WIN = (bf16_t*)(ws + WS_WIN); bf16_t* WOUT = (bf16_t*)(ws + WS_WOUT); bf16_t* RWT = (bf16_t*)(ws + WS_RWT); bf16_t* WGU = (bf16_t*)(ws + WS_WGU); bf16_t* WDN = (bf16_t*)(ws + WS_WDN); bf16_t* XB = (bf16_t*)(ws + WS_XB);
        const int gw = bid * NWAVES + wid, NGW = G * NWAVES;
        LAS unsigned char* wl = lds + wid * 9216;
        constexpr int I_IN = (PW / 64) * 16, I_OUT = 16 * 16, I_RW = 16;
        constexpr int N_IN = DEPTH * I_IN, N_OUT = DEPTH * I_OUT, N_RW = DEPTH * I_RW;
        constexpr int NITEMS = N_IN + N_OUT + N_RW;
        for (int it = gw; it < NITEMS; it += NGW) {
            int r = it;
            if (r < N_IN) { const int l = r / I_IN, q = r % I_IN, kb = q / (I_IN / 16), nb = q % (I_IN / 16); const int n = nb * 64 + lane; const int sc = win_src_col(n);
                cvt_item(w_in + (size_t)l * 1024 * NIN, NIN, sc, sc >= 0, WIN + ((size_t)l * PW + nb * 64) * 1024, kb * 64, wl, lane); continue; } r -= N_IN;
            if (r < N_OUT) { const int l = r / I_OUT, q = r % I_OUT, kb = q / (I_OUT / 16), nb = q % (I_OUT / 16); const int n = nb * 64 + lane;
                cvt_item(w_out + (size_t)l * 1024 * 1024, 1024, n, true, WOUT + ((size_t)l * 1024 + nb * 64) * 1024, kb * 64, wl, lane); continue; } r -= N_OUT;
            { const int l = r / I_RW, kb = r % I_RW;
              if (lane < 32) { const float* src = router_w + (size_t)l * 1024 * 32; bf16_t* dh = RWT + ((size_t)(l * 2 + 0) * 32 + lane) * 1024 + kb * 64; bf16_t* dl = RWT + ((size_t)(l * 2 + 1) * 32 + lane) * 1024 + kb * 64;
                  for (int j = 0; j < 64; ++j) { const float v = src[(size_t)(kb * 64 + j) * 32 + lane]; const bf16_t hb_ = f2bf(v); dh[j] = hb_; dl[j] = f2bf(v - bf2f(hb_)); } } }
        }
        for (size_t i = (size_t)bid * NTHR + tid; i < (size_t)T * D / 4; i += (size_t)G * NTHR) { const f32x4 v = *(const f32x4*)(x_in + i * 4); u32x2 w; w.x = cvtpk(v[0], v[1]); w.y = cvtpk(v[2], v[3]); *(u32x2*)(XB + i * 4) = w; }
    }
#endif
    xcd_barrier(bar, wid0);
    PROBE_SPIN(0); }

    run_layer<0>(lds, bar, qbc, G, bid, wid0);
    run_layer<1>(lds, bar, qbc, G, bid, wid0);
    run_layer<2>(lds, bar, qbc, G, bid, wid0);
    run_layer<3>(lds, bar, qbc, G, bid, wid0);
}

extern "C" void kernel_launch(void* const* d_in, const int* in_sizes, int n_in, void* d_out, int out_size, void* d_ws, size_t ws_size, hipStream_t stream) {
    static int grid = 0;
    if (grid == 0) {
        if (n_in != 21 || out_size != T * D || ws_size < WS_END) { fprintf(stderr, "kernel_launch: unexpected problem: n_in %d out %d ws %zu (need %zu)\n", n_in, out_size, ws_size, (size_t)WS_END); grid = -1; return; }
        int dev = 0, cus = 0, per_cu = 0;
        if (hipGetDevice(&dev) != hipSuccess || hipDeviceGetAttribute(&cus, hipDeviceAttributeMultiprocessorCount, dev) != hipSuccess) { fprintf(stderr, "kernel_launch: device query failed\n"); grid = -1; return; }
        if (hipFuncSetAttribute((const void*)mega_fwd, hipFuncAttributeMaxDynamicSharedMemorySize, LDS_BYTES) != hipSuccess) { fprintf(stderr, "kernel_launch: hipFuncSetAttribute failed\n"); grid = -1; return; }
        if (hipOccupancyMaxActiveBlocksPerMultiprocessor(&per_cu, (const void*)mega_fwd, NTHR, LDS_BYTES) != hipSuccess || per_cu < 1)
            fprintf(stderr, "kernel_launch: note: occupancy query reports %d workgroups per CU\n", per_cu);
        (void)hipGetLastError();
        grid = cus > 256 ? 256 : cus;
    }
    if (grid < 0) return;
    if (hipMemsetAsync((char*)d_ws + WS_CTL, 0, CTL_ZERO_BYTES, stream) != hipSuccess) { fprintf(stderr, "kernel_launch: memset failed\n"); return; }
    Args a{};
    for (int i = 0; i < 21; ++i) a.in[i] = (const float*)d_in[i];
    a.out = (float*)d_out; a.ws = (unsigned char*)d_ws;
    hipLaunchKernelGGL(mega_fwd, dim3(grid), dim3(NTHR), LDS_BYTES, stream, a);
    const hipError_t le = hipPeekAtLastError();
    if (le != hipSuccess) fprintf(stderr, "kernel_launch: launch failed: %s\n", hipGetErrorName(le));
}
```
